# Optimizing an MI355X kernel written in HIP

```python
import math
import jax, jax.numpy as jnp
from jax import lax
import numpy as np

D_MODEL = 1024
BATCH = 2
SEQ = 16384
DEPTH = 2

ATT_HEADS = 8
HEAD_DIM = 64
ATT_WIDTH = ATT_HEADS * HEAD_DIM
DILATIONS = ((128, 1), (512, 4), (2048, 16))
ATT_BLOCK = 128
ROPE_THETA = 10000.0

S5_WIDTH = 512
S5_GROUP = 16
S5_GROUPS = S5_WIDTH // S5_GROUP
S5_STATE = 64

RWKV_HEADS = 8
RWKV_HEAD = 64
RWKV_WIDTH = RWKV_HEADS * RWKV_HEAD
RWKV_DECAY_LORA = 64
RWKV_AAA_LORA = 64
RWKV_MV_LORA = 32
RWKV_GATE_LORA = 128
RWKV_GN_EPS = 64e-5

LRU_WIDTH = 512
LRU_BLOCKS = 8
LRU_BLOCK = LRU_WIDTH // LRU_BLOCKS
LRU_CONV = 4
LRU_C = 8.0

N_BRANCH = 4
D_FF = -(-8 * D_MODEL // (3 * 256)) * 256
IN_SIZES = (ATT_WIDTH, ATT_WIDTH, ATT_WIDTH, S5_WIDTH, RWKV_WIDTH, RWKV_WIDTH, RWKV_WIDTH, LRU_WIDTH, N_BRANCH * D_MODEL)
N_IN = 3 * ATT_WIDTH + S5_WIDTH + 3 * RWKV_WIDTH + LRU_WIDTH + N_BRANCH * D_MODEL
RMS_EPS = 1e-6

kernel_name = "hybrid_gated_parallel_mixers"


def rms_norm(x, g):
    xf = x.astype(jnp.float32)
    y = xf * lax.rsqrt(jnp.mean(xf * xf, axis=-1, keepdims=True) + RMS_EPS)
    return (y * g.astype(jnp.float32)).astype(x.dtype)


def rope_tables(seq, dim):
    inv = 1.0 / (ROPE_THETA ** (jnp.arange(0, dim, 2, dtype=jnp.float32) / dim))
    ang = jnp.arange(seq, dtype=jnp.float32)[:, None] * inv[None, :]
    return jnp.cos(ang), jnp.sin(ang)


def apply_rope(t, cos, sin):
    tf = t.astype(jnp.float32)
    t1, t2 = jnp.split(tf, 2, axis=-1)
    c, s = cos[None, :, None, :], sin[None, :, None, :]
    return jnp.concatenate([t1 * c - t2 * s, t2 * c + t1 * s], axis=-1)


def causal_shift(t):
    return jnp.pad(t, ((0, 0), (1, 0), (0, 0)))[:, :-1]


def banded_causal_attention(q, k, v, n_back):
    n, length, heads, dh = q.shape
    blk = ATT_BLOCK
    nb = -(-length // blk)
    pad = ((0, 0), (0, nb * blk - length), (0, 0), (0, 0))
    qb = jnp.pad(q, pad).reshape(n, nb, blk, heads, dh)
    kb = jnp.pad(k, pad).reshape(n, nb, blk, heads, dh)
    vb = jnp.pad(v, pad).reshape(n, nb, blk, heads, dh)

    def with_prev(t):
        prev = jnp.concatenate([jnp.zeros_like(t[:, :1]), t[:, :-1]], axis=1)
        return jnp.concatenate([prev, t], axis=2)

    kc, vc = with_prev(kb), with_prev(vb)
    sc = jnp.einsum('nbqhd,nbkhd->nbhqk', qb, kc) * (dh ** -0.5)
    kj = jnp.arange(2 * blk)[None, :]
    dist = jnp.arange(blk)[:, None] + blk - kj
    band = (dist >= 0) & (dist <= n_back)
    after_start = (jnp.arange(nb)[:, None] > 0) | (kj >= blk)
    mask = band[None, :, :] & after_start[:, None, :]
    sc = jnp.where(mask[None, :, None], sc, -jnp.inf)
    m = jnp.max(sc, axis=-1, keepdims=True)
    e = jnp.exp(sc - m)
    den = jnp.sum(e, axis=-1, keepdims=True)
    o = jnp.einsum('nbhqk,nbkhd->nbqhd', e / den, vc).reshape(n, nb * blk, heads, dh)[:, :length]
    lse = (m + jnp.log(den))[..., 0]
    lse = jnp.transpose(lse, (0, 1, 3, 2)).reshape(n, nb * blk, heads)[:, :length]
    return o, lse


def dilated_window_attention(q, k, v):
    b, s, h, dh = q.shape
    outs, lses = [], []
    for window, dil in DILATIONS:
        sub = s // dil

        def to_sub(t):
            return t.reshape(b, sub, dil, h, dh).transpose(0, 2, 1, 3, 4).reshape(b * dil, sub, h, dh)

        o, lse = banded_causal_attention(to_sub(q), to_sub(k), to_sub(v), window // dil)
        outs.append(o.reshape(b, dil, sub, h, dh).transpose(0, 2, 1, 3, 4).reshape(b, s, h, dh))
        lses.append(lse.reshape(b, dil, sub, h).transpose(0, 2, 1, 3).reshape(b, s, h))
    wts = jax.nn.softmax(jnp.stack(lses, axis=0), axis=0)
    return jnp.einsum('gbsh,gbshd->bshd', wts, jnp.stack(outs, axis=0)).reshape(b, s, h * dh)


def complex_linear_combine(e1, e2):
    a1r, a1i, b1r, b1i = e1
    a2r, a2i, b2r, b2i = e2
    return (a2r * a1r - a2i * a1i,
            a2r * a1i + a2i * a1r,
            a2r * b1r - a2i * b1i + b2r,
            a2r * b1i + a2i * b1r + b2i)


def s5_mixer(u, lam_re, lam_im, log_dt, b_re, b_im, c_re, c_im, d_skip, w_glu, b_glu):
    f32 = jnp.float32
    bsz, s, _ = u.shape
    uf = u.astype(f32)
    ug = uf.reshape(bsz, s, S5_GROUPS, S5_GROUP)
    lr, li = lam_re.astype(f32), lam_im.astype(f32)
    dt = jnp.exp(log_dt.astype(f32))[:, None]
    mag = jnp.exp(lr * dt)
    ab_re, ab_im = mag * jnp.cos(li * dt), mag * jnp.sin(li * dt)
    nr = ab_re - 1.0
    den = lr * lr + li * li
    f_re = (nr * lr + ab_im * li) / den
    f_im = (ab_im * lr - nr * li) / den
    bb_re = f_re[..., None] * b_re - f_im[..., None] * b_im
    bb_im = f_re[..., None] * b_im + f_im[..., None] * b_re
    bu_re = jnp.einsum('bsgc,gpc->bsgp', ug, bb_re)
    bu_im = jnp.einsum('bsgc,gpc->bsgp', ug, bb_im)
    a_re = jnp.broadcast_to(ab_re, (1, s) + ab_re.shape)
    a_im = jnp.broadcast_to(ab_im, (1, s) + ab_im.shape)
    _, _, x_re, x_im = lax.associative_scan(complex_linear_combine, (a_re, a_im, bu_re, bu_im), axis=1)
    y = jnp.einsum('bsgp,gcp->bsgc', x_re, c_re) - jnp.einsum('bsgp,gcp->bsgc', x_im, c_im)
    y = jax.nn.gelu(y.reshape(bsz, s, S5_WIDTH) + d_skip * uf)
    val, gate = jnp.split(y @ w_glu + b_glu, 2, axis=-1)
    return val * jax.nn.sigmoid(gate)


def wkv7_scan(r, w, k, v, a, b):
    bsz, _, h, n = r.shape

    def step(state, inp):
        r_t, w_t, k_t, v_t, a_t, b_t = inp
        sa = jnp.einsum('bhij,bhj->bhi', state, a_t)
        state = state * w_t[:, :, None, :] + sa[..., None] * b_t[:, :, None, :] + v_t[..., None] * k_t[:, :, None, :]
        return state, jnp.einsum('bhij,bhj->bhi', state, r_t)

    xs = tuple(jnp.moveaxis(t, 1, 0) for t in (r, w, k, v, a, b))
    _, ys = lax.scan(step, jnp.zeros((bsz, h, n, n), jnp.float32), xs)
    return jnp.moveaxis(ys, 0, 1)


def rwkv7_time_mix(h, r_p, k_p, v_p, mu_rkv, mu_wag, w0, w1, w2, a0, a1, a2, g1, g2,
                   k_k, k_a, r_k, gn_w, gn_b, v_res):
    f32 = jnp.float32
    bsz, s, _ = h.shape
    hf = h.astype(f32)
    dh = causal_shift(hf) - hf
    xw, xa, xg = (hf + dh * mu_wag[i] for i in range(3))

    def lerp(p, mu):
        p = p.astype(f32)
        return p + (causal_shift(p) - p) * mu

    r = lerp(r_p, mu_rkv[0])
    k = lerp(k_p, mu_rkv[1])
    v = lerp(v_p, mu_rkv[2])
    w_log = -jax.nn.softplus(-(w0 + jnp.tanh(xw @ w1) @ w2)) - 0.5
    decay = jnp.exp(-jnp.exp(w_log))
    if v_res is not None:
        v_first, mu_v, v0, v1, v2 = v_res
        xv = hf + dh * mu_v
        v = v + (v_first - v) * jax.nn.sigmoid(v0 + (xv @ v1) @ v2)
    a = jax.nn.sigmoid(a0 + (xa @ a1) @ a2)
    g = jax.nn.sigmoid(xg @ g1) @ g2

    def heads(t):
        return t.reshape(bsz, s, RWKV_HEADS, RWKV_HEAD)

    kk = heads(k * k_k)
    kk = kk * lax.rsqrt(jnp.maximum(jnp.sum(kk * kk, axis=-1, keepdims=True), 1e-24))
    k = k * (1.0 + (a - 1.0) * k_a)
    rh, kh, vh = heads(r), heads(k), heads(v)
    y = wkv7_scan(rh, heads(decay), kh, vh, -kk, kk * heads(a))
    mean = jnp.mean(y, axis=-1, keepdims=True)
    var = jnp.mean(jnp.square(y - mean), axis=-1, keepdims=True)
    y = ((y - mean) * lax.rsqrt(var + RWKV_GN_EPS)).reshape(bsz, s, RWKV_WIDTH) * gn_w + gn_b
    bonus = jnp.sum(rh * kh * r_k, axis=-1, keepdims=True) * vh
    y = y + bonus.reshape(bsz, s, RWKV_WIDTH)
    return y * g, v


def linear_combine(e1, e2):
    a1, b1 = e1
    a2, b2 = e2
    return a1 * a2, a2 * b1 + b2


def rglru_mixer(x_in, conv_w, conv_b, w_a, b_a, w_x, b_x, lam):
    f32 = jnp.float32
    bsz, s, c = x_in.shape
    xc = lax.conv_general_dilated(x_in.astype(f32), conv_w.astype(f32)[:, None, :], window_strides=(1,),
                                  padding=((LRU_CONV - 1, 0),), dimension_numbers=('NWC', 'WIO', 'NWC'),
                                  feature_group_count=c) + conv_b
    xb = xc.reshape(bsz, s, LRU_BLOCKS, LRU_BLOCK)
    r = jax.nn.sigmoid(jnp.einsum('bshi,hij->bshj', xb, w_a).reshape(bsz, s, c) + b_a)
    i = jax.nn.sigmoid(jnp.einsum('bshi,hij->bshj', xb, w_x).reshape(bsz, s, c) + b_x)
    log_a = -LRU_C * r * jax.nn.softplus(-lam.astype(f32))
    a = jnp.exp(log_a)
    inp = jnp.sqrt(-jnp.expm1(2.0 * log_a)) * (i * xc)
    _, hs = lax.associative_scan(linear_combine, (a, inp), axis=1)
    return hs


def setup_inputs(seed: int = 0) -> dict:
    key = jax.random.key(seed)
    ks = iter(jax.random.split(key, 64))
    f32 = jnp.float32
    L, D, F = DEPTH, D_MODEL, D_FF
    G, P = S5_GROUPS, S5_STATE

    def nrm(shape, scale):
        return jax.random.normal(next(ks), shape, f32) * scale

    def unif(shape, lo, hi):
        return jax.random.uniform(next(ks), shape, f32, lo, hi)

    lru_u = unif((L, LRU_WIDTH), 0.9, 0.999)
    lru_a0 = lru_u ** (1.0 / LRU_C)
    return {
        "x": nrm((BATCH, SEQ, D), 1.0),
        "norm_mix": 1.0 + nrm((L, D), 0.02),
        "w_in": nrm((L, D, N_IN), D ** -0.5),
        "s5_lam_re": -0.5 * jnp.exp(nrm((L, G, P), 0.02)),
        "s5_lam_im": math.pi * jnp.arange(P, dtype=f32) + nrm((L, G, P), 0.01),
        "s5_log_dt": unif((L, G), math.log(1e-3), math.log(1e-1)),
        "s5_b_re": nrm((L, G, P, S5_GROUP), (2 * S5_GROUP) ** -0.5),
        "s5_b_im": nrm((L, G, P, S5_GROUP), (2 * S5_GROUP) ** -0.5),
        "s5_c_re": nrm((L, G, S5_GROUP, P), 0.5),
        "s5_c_im": nrm((L, G, S5_GROUP, P), 0.5),
        "s5_d": nrm((L, S5_WIDTH), 1.0),
        "s5_w_glu": nrm((L, S5_WIDTH, 2 * S5_WIDTH), S5_WIDTH ** -0.5),
        "s5_b_glu": nrm((L, 2 * S5_WIDTH), 0.02),
        "rw_mu_rkv": unif((L, 3, RWKV_WIDTH), 0.0, 1.0),
        "rw_mu_wag": unif((L, 3, D), 0.0, 1.0),
        "rw_w0": unif((L, RWKV_WIDTH), -6.0, -1.0),
        "rw_w1": nrm((L, D, RWKV_DECAY_LORA), D ** -0.5),
        "rw_w2": nrm((L, RWKV_DECAY_LORA, RWKV_WIDTH), 0.1 * RWKV_DECAY_LORA ** -0.5),
        "rw_a0": nrm((L, RWKV_WIDTH), 0.1),
        "rw_a1": nrm((L, D, RWKV_AAA_LORA), D ** -0.5),
        "rw_a2": nrm((L, RWKV_AAA_LORA, RWKV_WIDTH), 0.5 * RWKV_AAA_LORA ** -0.5),
        "rw_g1": nrm((L, D, RWKV_GATE_LORA), D ** -0.5),
        "rw_g2": nrm((L, RWKV_GATE_LORA, RWKV_WIDTH), RWKV_GATE_LORA ** -0.5),
        "rw_k_k": 0.85 + nrm((L, RWKV_WIDTH), 0.02),
        "rw_k_a": 1.0 + nrm((L, RWKV_WIDTH), 0.02),
        "rw_r_k": nrm((L, RWKV_HEADS, RWKV_HEAD), 0.1),
        "rw_gn_w": 1.0 + nrm((L, RWKV_WIDTH), 0.02),
        "rw_gn_b": nrm((L, RWKV_WIDTH), 0.02),
        "rw_mu_v": unif((L - 1, D), 0.0, 1.0),
        "rw_v0": 0.5 + nrm((L - 1, RWKV_WIDTH), 0.1),
        "rw_v1": nrm((L - 1, D, RWKV_MV_LORA), D ** -0.5),
        "rw_v2": nrm((L - 1, RWKV_MV_LORA, RWKV_WIDTH), 0.5 * RWKV_MV_LORA ** -0.5),
        "lru_conv_w": nrm((L, LRU_CONV, LRU_WIDTH), LRU_CONV ** -0.5),
        "lru_conv_b": nrm((L, LRU_WIDTH), 0.02),
        "lru_w_a": nrm((L, LRU_BLOCKS, LRU_BLOCK, LRU_BLOCK), LRU_BLOCK ** -0.5),
        "lru_b_a": nrm((L, LRU_WIDTH), 0.02),
        "lru_w_x": nrm((L, LRU_BLOCKS, LRU_BLOCK, LRU_BLOCK), LRU_BLOCK ** -0.5),
        "lru_b_x": nrm((L, LRU_WIDTH), 0.02),
        "lru_lam": jnp.log(lru_a0) - jnp.log1p(-lru_a0),
        "w_branch": nrm((L, N_BRANCH, ATT_WIDTH, D), ATT_WIDTH ** -0.5),
        "w_out": nrm((L, D, D), D ** -0.5),
        "norm_ffn": 1.0 + nrm((L, D), 0.02),
        "w_ffn_gate": nrm((L, D, F), D ** -0.5),
        "w_ffn_up": nrm((L, D, F), D ** -0.5),
        "w_ffn_down": nrm((L, F, D), F ** -0.5),
        "norm_final": 1.0 + nrm((D,), 0.02),
    }


def reference(x, norm_mix, w_in,
              s5_lam_re, s5_lam_im, s5_log_dt, s5_b_re, s5_b_im, s5_c_re, s5_c_im, s5_d, s5_w_glu, s5_b_glu,
              rw_mu_rkv, rw_mu_wag, rw_w0, rw_w1, rw_w2, rw_a0, rw_a1, rw_a2, rw_g1, rw_g2,
              rw_k_k, rw_k_a, rw_r_k, rw_gn_w, rw_gn_b, rw_mu_v, rw_v0, rw_v1, rw_v2,
              lru_conv_w, lru_conv_b, lru_w_a, lru_b_a, lru_w_x, lru_b_x, lru_lam,
              w_branch, w_out, norm_ffn, w_ffn_gate, w_ffn_up, w_ffn_down, norm_final):
    f32 = jnp.float32
    b, s, _ = x.shape
    cos, sin = rope_tables(s, HEAD_DIM)
    splits = [int(c) for c in np.cumsum(IN_SIZES)[:-1]]

    def att_heads(t):
        return t.reshape(b, s, ATT_HEADS, HEAD_DIM)

    v_first = None
    for l in range(DEPTH):
        h = rms_norm(x, norm_mix[l])
        proj = h @ w_in[l]
        q, k, v, u, r_p, k_p, v_p, x_lru, gate_logits = jnp.split(proj, splits, axis=-1)

        y_a = dilated_window_attention(apply_rope(att_heads(q), cos, sin),
                                       apply_rope(att_heads(k), cos, sin),
                                       att_heads(v).astype(f32))
        y_b = s5_mixer(u, s5_lam_re[l], s5_lam_im[l], s5_log_dt[l], s5_b_re[l], s5_b_im[l],
                       s5_c_re[l], s5_c_im[l], s5_d[l], s5_w_glu[l], s5_b_glu[l])
        v_res = None if l == 0 else (v_first, rw_mu_v[l - 1], rw_v0[l - 1], rw_v1[l - 1], rw_v2[l - 1])
        y_c, v_c = rwkv7_time_mix(h, r_p, k_p, v_p, rw_mu_rkv[l], rw_mu_wag[l], rw_w0[l], rw_w1[l], rw_w2[l],
                                  rw_a0[l], rw_a1[l], rw_a2[l], rw_g1[l], rw_g2[l], rw_k_k[l], rw_k_a[l],
                                  rw_r_k[l], rw_gn_w[l], rw_gn_b[l], v_res)
        if l == 0:
            v_first = v_c
        y_d = rglru_mixer(x_lru, lru_conv_w[l], lru_conv_b[l], lru_w_a[l], lru_b_a[l],
                          lru_w_x[l], lru_b_x[l], lru_lam[l])

        gates = jax.nn.sigmoid(gate_logits.astype(f32)).reshape(b, s, N_BRANCH, D_MODEL)
        merged = gates[:, :, 0] * (y_a @ w_branch[l, 0])
        for n, y_n in enumerate((y_b, y_c, y_d), start=1):
            merged = merged + gates[:, :, n] * (y_n @ w_branch[l, n])
        x = x + (merged @ w_out[l]).astype(x.dtype)

        h2 = rms_norm(x, norm_ffn[l])
        ff = (jax.nn.silu(h2 @ w_ffn_gate[l]) * (h2 @ w_ffn_up[l])) @ w_ffn_down[l]
        x = x + ff.astype(x.dtype)
    return rms_norm(x, norm_final)
```

```cpp
#include <hip/hip_runtime.h>
#include <hip/hip_cooperative_groups.h>
#include <cstdio>
#include <cstring>
namespace cg = cooperative_groups;

#ifndef MEGA
#define MEGA 1
#endif

typedef unsigned short bf16_t;
typedef __attribute__((ext_vector_type(8))) short bf16x8;
typedef __attribute__((ext_vector_type(16))) float f32x16;
typedef __attribute__((ext_vector_type(4))) short s16x4;
typedef __attribute__((ext_vector_type(2))) __bf16 bf2_t;

#define DI __device__ __forceinline__

constexpr int SEQ = 16384;
constexpr int TOK = 32768;
constexpr int DM = 1024;
constexpr int NIN = 8192;
constexpr int DFF = 2816;
constexpr int LC5 = 128, NCH5 = SEQ / LC5;
constexpr int LCL = 128, NCHL = SEQ / LCL;
constexpr int LCR = 128, NCHR = SEQ / LCR;
constexpr int SMEM_BYTES = 73728;

enum {
  I_X = 0, I_NORM_MIX, I_W_IN, I_S5_LAM_RE, I_S5_LAM_IM, I_S5_LOG_DT, I_S5_B_RE, I_S5_B_IM, I_S5_C_RE, I_S5_C_IM,
  I_S5_D, I_S5_W_GLU, I_S5_B_GLU, I_RW_MU_RKV, I_RW_MU_WAG, I_RW_W0, I_RW_W1, I_RW_W2, I_RW_A0, I_RW_A1, I_RW_A2,
  I_RW_G1, I_RW_G2, I_RW_K_K, I_RW_K_A, I_RW_R_K, I_RW_GN_W, I_RW_GN_B, I_RW_MU_V, I_RW_V0, I_RW_V1, I_RW_V2,
  I_LRU_CONV_W, I_LRU_CONV_B, I_LRU_W_A, I_LRU_B_A, I_LRU_W_X, I_LRU_B_X, I_LRU_LAM, I_W_BRANCH, I_W_OUT,
  I_NORM_FFN, I_W_FFN_GATE, I_W_FFN_UP, I_W_FFN_DOWN, I_NORM_FINAL, I_COUNT
};

constexpr size_t al256(size_t x) { return (x + 255) & ~(size_t)255; }
constexpr size_t O_Wqkv = 0;
constexpr size_t O_Wux = O_Wqkv + al256((size_t)1536 * 1024 * 2);
constexpr size_t O_Wrkv = O_Wux + al256((size_t)1024 * 1024 * 2);
constexpr size_t O_Wgate = O_Wrkv + al256((size_t)1536 * 1024 * 2);
constexpr size_t O_Lora1 = O_Wgate + al256((size_t)4096 * 1024 * 2);
constexpr size_t O_W2T = O_Lora1 + al256((size_t)320 * 2048 * 2);
constexpr size_t O_A2T = O_W2T + al256((size_t)512 * 64 * 2);
constexpr size_t O_G2T = O_A2T + al256((size_t)512 * 64 * 2);
constexpr size_t O_V2T = O_G2T + al256((size_t)512 * 128 * 2);
constexpr size_t O_GluT = O_V2T + al256((size_t)512 * 64 * 2);
constexpr size_t O_BranchT = O_GluT + al256((size_t)1024 * 512 * 2);
constexpr size_t O_WoutT = O_BranchT + al256((size_t)4 * 1024 * 512 * 2);
constexpr size_t O_FfnGU = O_WoutT + al256((size_t)1024 * 1024 * 2);
constexpr size_t O_FfnDown = O_FfnGU + al256((size_t)2 * DFF * 1024 * 2);
constexpr size_t O_ropeC = O_FfnDown + al256((size_t)1024 * DFF * 2);
constexpr size_t O_ropeS = O_ropeC + al256((size_t)SEQ * 32 * 4);
constexpr size_t O_s5A = O_ropeS + al256((size_t)SEQ * 32 * 4);
constexpr size_t O_s5AL = O_s5A + al256(2048 * 2 * 4);
constexpr size_t O_s5BB = O_s5AL + al256(2048 * 2 * 4);
constexpr size_t O_s5st = O_s5BB + al256(2048 * 32 * 4);
constexpr size_t O_lrust = O_s5st + al256((size_t)64 * NCH5 * 64 * 2 * 4);
constexpr size_t O_lse = O_lrust + al256((size_t)1024 * NCHL * 2 * 4);
constexpr size_t O_vbuf = O_lse + al256((size_t)3 * TOK * 8 * 4);
constexpr size_t O_h = O_vbuf + al256((size_t)TOK * 512 * 2);
constexpr size_t O_ya = O_h + al256((size_t)TOK * 1024 * 2);
constexpr size_t O_yb = O_ya + al256((size_t)TOK * 512 * 2);
constexpr size_t O_yc = O_yb + al256((size_t)TOK * 512 * 2);
constexpr size_t O_yd = O_yc + al256((size_t)TOK * 512 * 2);
constexpr size_t O_TR = O_yd + al256((size_t)TOK * 512 * 2);
constexpr size_t O_bar = O_TR + (size_t)224 * 1048576;
constexpr size_t WS_NEED = O_bar + 16384;

struct KArgs {
  const float* in[46];
  char* ws;
  float* X;
};

struct Params {
  const float* const* in;
  bf16_t *Wqkv, *Wux, *Wrkv, *Wgate, *Lora1, *W2T, *A2T, *G2T, *V2T, *GluT, *BranchT, *WoutT, *FfnGU, *FfnDown;
  float *ropeC, *ropeS, *s5A, *s5AL, *s5BB, *s5st, *lrust, *lse;
  bf16_t *vbuf, *h, *ya, *yb, *yc, *yd;
  char* TR;
  float* X;
};

DI Params make_params(const KArgs& k) {
  Params p;
  p.in = k.in;
  char* ws = k.ws;
  p.Wqkv = (bf16_t*)(ws + O_Wqkv); p.Wux = (bf16_t*)(ws + O_Wux); p.Wrkv = (bf16_t*)(ws + O_Wrkv); p.Wgate = (bf16_t*)(ws + O_Wgate);
  p.Lora1 = (bf16_t*)(ws + O_Lora1); p.W2T = (bf16_t*)(ws + O_W2T); p.A2T = (bf16_t*)(ws + O_A2T); p.G2T = (bf16_t*)(ws + O_G2T);
  p.V2T = (bf16_t*)(ws + O_V2T); p.GluT = (bf16_t*)(ws + O_GluT); p.BranchT = (bf16_t*)(ws + O_BranchT); p.WoutT = (bf16_t*)(ws + O_WoutT);
  p.FfnGU = (bf16_t*)(ws + O_FfnGU); p.FfnDown = (bf16_t*)(ws + O_FfnDown);
  p.ropeC = (float*)(ws + O_ropeC); p.ropeS = (float*)(ws + O_ropeS); p.s5A = (float*)(ws + O_s5A); p.s5AL = (float*)(ws + O_s5AL);
  p.s5BB = (float*)(ws + O_s5BB); p.s5st = (float*)(ws + O_s5st); p.lrust = (float*)(ws + O_lrust); p.lse = (float*)(ws + O_lse);
  p.vbuf = (bf16_t*)(ws + O_vbuf); p.h = (bf16_t*)(ws + O_h); p.ya = (bf16_t*)(ws + O_ya); p.yb = (bf16_t*)(ws + O_yb);
  p.yc = (bf16_t*)(ws + O_yc); p.yd = (bf16_t*)(ws + O_yd);
  p.TR = ws + O_TR; p.X = k.X;
  return p;
}

DI int tidx() { int t = __builtin_amdgcn_workitem_id_x(); asm volatile("" : "+v"(t)); return t & 255; }
DI bf16_t f2bf(float x) { unsigned u = __float_as_uint(x); u += 0x7fffu + ((u >> 16) & 1u); return (bf16_t)(u >> 16); }
DI float bf2f(bf16_t b) { return __uint_as_float(((unsigned)b) << 16); }
DI float rl(float x, int l) { return __int_as_float(__builtin_amdgcn_readlane(__float_as_int(x), l)); }
DI float sigmoidf_(float x) { return __builtin_amdgcn_rcpf(1.f + __expf(-x)); }
DI float softplusf_(float z) { return fmaxf(z, 0.f) + __logf(1.f + __expf(-fabsf(z))); }
DI float tanhf_(float x) { return 1.f - 2.f * __builtin_amdgcn_rcpf(1.f + __expf(2.f * x)); }
DI float wave_sum(float x) {
  x += __shfl_xor(x, 32); x += __shfl_xor(x, 16); x += __shfl_xor(x, 8);
  x += __shfl_xor(x, 4); x += __shfl_xor(x, 2); x += __shfl_xor(x, 1);
  return x;
}
DI int first_item(int base, int idx, int stride) { int r = base % stride; int f = idx - r; if (f < 0) f += stride; return f; }

constexpr int LP = 72;

typedef __attribute__((ext_vector_type(4))) unsigned u32x4;
template <int NT, int AMODE, int PF = 2>
DI void gemm_acc(f32x16 (&acc)[2][NT], const bf16_t* __restrict__ A, int lda, int row0,
                 const bf16_t* __restrict__ Bt, int ldb, int brow0, int K, bf16_t* sm) {
  const int tid = tidx();
  const int lane = tid & 63, wave = tid >> 6;
  const int r = lane & 31, hh = lane >> 5;
  const int wm = wave >> 1, wn = wave & 1;
  bf16_t* sA = sm;
  bf16_t* sB = sm + 2 * 128 * LP;
  const int KT = K / 64;
  u32x4 ra0[4], rb0[2 * NT], ra1[4], rb1[2 * NT];

#define GLOAD(KT_, RA, RB)                                                                      \
  {                                                                                             \
    _Pragma("unroll") for (int i = 0; i < 4; i++) {                                             \
      int id = tid + 256 * i; int row = id >> 3, kc = id & 7;                                   \
      int k = (KT_) * 64 + kc * 8;                                                              \
      if (AMODE == 0) {                                                                         \
        RA[i] = *(const u32x4*)(A + (size_t)(row0 + row) * lda + k);                            \
      } else {                                                                                  \
        int grow = row0 + row;                                                                  \
        if (k < 1024) RA[i] = *(const u32x4*)(A + (size_t)grow * 1024 + k);                     \
        else if ((grow & (SEQ - 1)) == 0) RA[i] = (u32x4){0u, 0u, 0u, 0u};                       \
        else RA[i] = *(const u32x4*)(A + (size_t)(grow - 1) * 1024 + (k - 1024));               \
      }                                                                                         \
    }                                                                                           \
    _Pragma("unroll") for (int i = 0; i < 2 * NT; i++) {                                        \
      int id = tid + 256 * i; int row = id >> 3, kc = id & 7;                                   \
      RB[i] = *(const u32x4*)(Bt + (size_t)(brow0 + row) * ldb + (KT_) * 64 + kc * 8);          \
    }                                                                                           \
  }
#define SSTORE(ST_, RA, RB)                                                                     \
  {                                                                                             \
    _Pragma("unroll") for (int i = 0; i < 4; i++) {                                             \
      int id = tid + 256 * i; int row = id >> 3, kc = id & 7;                                   \
      *(u32x4*)(sA + (ST_) * 128 * LP + row * LP + kc * 8) = RA[i];                             \
    }                                                                                           \
    _Pragma("unroll") for (int i = 0; i < 2 * NT; i++) {                                        \
      int id = tid + 256 * i; int row = id >> 3, kc = id & 7;                                   \
      *(u32x4*)(sB + (ST_) * 128 * LP + row * LP + kc * 8) = RB[i];                             \
    }                                                                                           \
  }
  auto compute = [&](int st) __attribute__((always_inline)) {
    const bf16_t* a_base = sA + st * 128 * LP + (wm * 64 + r) * LP + hh * 8;
    const bf16_t* b_base = sB + st * 128 * LP + (wn * 32 * NT + r) * LP + hh * 8;
#pragma unroll
    for (int ks = 0; ks < 4; ks++) {
      bf16x8 af[2], bfr[NT];
#pragma unroll
      for (int mi = 0; mi < 2; mi++) af[mi] = *(const bf16x8*)(a_base + mi * 32 * LP + ks * 16);
#pragma unroll
      for (int ni = 0; ni < NT; ni++) bfr[ni] = *(const bf16x8*)(b_base + ni * 32 * LP + ks * 16);
#pragma unroll
      for (int mi = 0; mi < 2; mi++)
#pragma unroll
        for (int ni = 0; ni < NT; ni++)
          acc[mi][ni] = __builtin_amdgcn_mfma_f32_32x32x16_bf16(af[mi], bfr[ni], acc[mi][ni], 0, 0, 0);
    }
  };

  if (PF == 1) {
    GLOAD(0, ra0, rb0)
    SSTORE(0, ra0, rb0)
    __syncthreads();
#pragma unroll 1
    for (int kt = 0; kt < KT; kt++) {
      const int st = kt & 1;
      if (kt + 1 < KT) GLOAD(kt + 1, ra0, rb0)
      compute(st);
      if (kt + 1 < KT) SSTORE(st ^ 1, ra0, rb0)
      __syncthreads();
    }
    return;
  }
  GLOAD(0, ra0, rb0)
  if (KT > 1) GLOAD(1, ra1, rb1)
  SSTORE(0, ra0, rb0)
  __syncthreads();
#pragma unroll 1
  for (int kt = 0; kt < KT; kt += 2) {
    if (kt + 2 < KT) GLOAD(kt + 2, ra0, rb0)
    compute(0);
    if (kt + 1 < KT) SSTORE(1, ra1, rb1)
    __syncthreads();
    if (kt + 1 >= KT) break;
    if (kt + 3 < KT) GLOAD(kt + 3, ra1, rb1)
    compute(1);
    if (kt + 2 < KT) SSTORE(0, ra0, rb0)
    __syncthreads();
  }
#undef GLOAD
#undef SSTORE
}

template <int NT>
DI void zero_acc(f32x16 (&acc)[2][NT]) {
#pragma unroll
  for (int mi = 0; mi < 2; mi++)
#pragma unroll
    for (int ni = 0; ni < NT; ni++)
#pragma unroll
      for (int i = 0; i < 16; i++) acc[mi][ni][i] = 0.f;
}


#define XT_LOOP(NTN, BASE) \
  for (int pos_ = first_item((BASE), (int)(blockIdx.x >> 3), (int)(gridDim.x >> 3)); pos_ < 32 * (NTN); pos_ += (int)(gridDim.x >> 3))
DI void xt_decode(int pos, int ntn, int& mt, int& nt) {
  const int s = pos / (8 * ntn); const int rem = pos - s * 8 * ntn;
  nt = rem >> 3; mt = 32 * (int)(blockIdx.x & 7) + 8 * s + (rem & 7);
}

#define EPI_VARS                                                     \
  const int lane_ = tidx() & 63, wave_ = tidx() >> 6;      \
  const int er = lane_ & 31, eh = lane_ >> 5, ewm = wave_ >> 1, ewn = wave_ & 1;
#define EPI_ROW(mi, i) (row0 + ewm * 64 + (mi) * 32 + ((i) & 3) + 8 * ((i) >> 2) + 4 * eh)


constexpr int LP4 = 40;
DI void gemm_acc4(f32x16 (&acc)[4][2], const bf16_t* __restrict__ A, int lda, int row0,
                  const bf16_t* __restrict__ Bt, int ldb, int brow0, int K, bf16_t* sm) {
  const int tid = tidx();
  const int lane = tid & 63, wave = tid >> 6;
  const int r = lane & 31, hh = lane >> 5;
  const int wm = wave >> 1, wn = wave & 1;
  bf16_t* sA = sm;
  bf16_t* sB = sm + 2 * 256 * LP4;
  const int KT = K / 32;
  u32x4 ra0[4], rb0[2], ra1[4], rb1[2];
#define GLOAD4(KT_, RA, RB)                                                                     \
  {                                                                                             \
    _Pragma("unroll") for (int i = 0; i < 4; i++) {                                             \
      int id = tid + 256 * i; int row = id >> 2, kc = id & 3;                                   \
      RA[i] = *(const u32x4*)(A + (size_t)(row0 + row) * lda + (KT_) * 32 + kc * 8);            \
    }                                                                                           \
    _Pragma("unroll") for (int i = 0; i < 2; i++) {                                             \
      int id = tid + 256 * i; int row = id >> 2, kc = id & 3;                                   \
      RB[i] = *(const u32x4*)(Bt + (size_t)(brow0 + row) * ldb + (KT_) * 32 + kc * 8);          \
    }                                                                                           \
  }
#define SSTORE4(ST_, RA, RB)                                                                    \
  {                                                                                             \
    _Pragma("unroll") for (int i = 0; i < 4; i++) {                                             \
      int id = tid + 256 * i; int row = id >> 2, kc = id & 3;                                   \
      *(u32x4*)(sA + (ST_) * 256 * LP4 + row * LP4 + kc * 8) = RA[i];                           \
    }                                                                                           \
    _Pragma("unroll") for (int i = 0; i < 2; i++) {                                             \
      int id = tid + 256 * i; int row = id >> 2, kc = id & 3;                                   \
      *(u32x4*)(sB + (ST_) * 128 * LP4 + row * LP4 + kc * 8) = RB[i];                           \
    }                                                                                           \
  }
  auto compute = [&](int st) __attribute__((always_inline)) {
    const bf16_t* a_base = sA + st * 256 * LP4 + (wm * 128 + r) * LP4 + hh * 8;
    const bf16_t* b_base = sB + st * 128 * LP4 + (wn * 64 + r) * LP4 + hh * 8;
#pragma unroll
    for (int ks = 0; ks < 2; ks++) {
      bf16x8 af[4], bfr[2];
#pragma unroll
      for (int mi = 0; mi < 4; mi++) af[mi] = *(const bf16x8*)(a_base + mi * 32 * LP4 + ks * 16);
#pragma unroll
      for (int ni = 0; ni < 2; ni++) bfr[ni] = *(const bf16x8*)(b_base + ni * 32 * LP4 + ks * 16);
#pragma unroll
      for (int mi = 0; mi < 4; mi++)
#pragma unroll
        for (int ni = 0; ni < 2; ni++)
          acc[mi][ni] = __builtin_amdgcn_mfma_f32_32x32x16_bf16(af[mi], bfr[ni], acc[mi][ni], 0, 0, 0);
    }
  };
  GLOAD4(0, ra0, rb0)
  if (KT > 1) GLOAD4(1, ra1, rb1)
  SSTORE4(0, ra0, rb0)
  __syncthreads();
#pragma unroll 1
  for (int kt = 0; kt < KT; kt += 2) {
    if (kt + 2 < KT) GLOAD4(kt + 2, ra0, rb0)
    compute(0);
    if (kt + 1 < KT) SSTORE4(1, ra1, rb1)
    __syncthreads();
    if (kt + 1 >= KT) break;
    if (kt + 3 < KT) GLOAD4(kt + 3, ra1, rb1)
    compute(1);
    if (kt + 2 < KT) SSTORE4(0, ra0, rb0)
    __syncthreads();
  }
#undef GLOAD4
#undef SSTORE4
}
DI void zero_acc4(f32x16 (&acc)[4][2]) {
#pragma unroll
  for (int mi = 0; mi < 4; mi++)
#pragma unroll
    for (int ni = 0; ni < 2; ni++)
#pragma unroll
      for (int i = 0; i < 16; i++) acc[mi][ni][i] = 0.f;
}
#define XT4_LOOP(NTN, BASE) \
  for (int pos_ = first_item((BASE), (int)(blockIdx.x >> 3), (int)(gridDim.x >> 3)); pos_ < 16 * (NTN); pos_ += (int)(gridDim.x >> 3))
DI void xt4_decode(int pos, int ntn, int& mt, int& nt) {
  const int s = pos / (8 * ntn); const int rem = pos - s * 8 * ntn;
  nt = rem >> 3; mt = 16 * (int)(blockIdx.x & 7) + 8 * s + (rem & 7);
}
#define EPI_ROW4(mi, i) (row0 + ewm * 128 + (mi) * 32 + ((i) & 3) + 8 * ((i) >> 2) + 4 * eh)

template <class F>
DI void transpose_job(bf16_t* dst, int N, int K, F f, float* tile, int& base) {
  const int tid = tidx();
  const int ntn = N / 64, ntiles = ntn * (K / 64);
  for (int t = first_item(base, blockIdx.x, gridDim.x); t < ntiles; t += gridDim.x) {
    const int n0 = (t % ntn) * 64, k0 = (t / ntn) * 64;
#pragma unroll 4
    for (int i = 0; i < 16; i++) {
      int k = (tid >> 6) + 4 * i, n = tid & 63;
      tile[k * 65 + n] = f(n0 + n, k0 + k);
    }
    __syncthreads();
#pragma unroll 4
    for (int i = 0; i < 16; i++) {
      int n = (tid >> 6) + 4 * i, k = tid & 63;
      dst[(size_t)(n0 + n) * K + k0 + k] = f2bf(tile[k * 65 + n]);
    }
    __syncthreads();
  }
  base += ntiles;
}

DI int interleave_col(int n) {
  return (n >> 7) * 64 + ((n >> 6) & 1) * 32 + (n & 31);
}

DI void phase_prep(const Params& p, int l, float* smf, int part) {
  int base = 0;
  if (part == 2) {
    const float* fg = p.in[I_W_FFN_GATE] + (size_t)l * 1024 * DFF;
    const float* fu = p.in[I_W_FFN_UP] + (size_t)l * 1024 * DFF;
    const float* fd = p.in[I_W_FFN_DOWN] + (size_t)l * DFF * 1024;
    transpose_job(p.FfnGU, 2 * DFF, 1024, [&](int n, int k) {
      int j = interleave_col(n);
      return ((n >> 5) & 1) ? fu[(size_t)k * DFF + j] : fg[(size_t)k * DFF + j];
    }, smf, base);
    transpose_job(p.FfnDown, 1024, DFF, [&](int n, int k) { return fd[(size_t)k * 1024 + n]; }, smf, base);
    return;
  }
  const float* w_in = p.in[I_W_IN] + (size_t)l * DM * NIN;
  transpose_job(p.Wqkv, 1536, 1024, [&](int n, int k) { return w_in[(size_t)k * NIN + n]; }, smf, base);
  transpose_job(p.Wux, 1024, 1024, [&](int n, int k) { return w_in[(size_t)k * NIN + (n < 512 ? 1536 + n : 3584 + n - 512)]; }, smf, base);
  transpose_job(p.Wrkv, 1536, 1024, [&](int n, int k) { return w_in[(size_t)k * NIN + 2048 + n]; }, smf, base);
  transpose_job(p.Wgate, 4096, 1024, [&](int n, int k) { return w_in[(size_t)k * NIN + 4096 + n]; }, smf, base);
  {
    const float* w1 = p.in[I_RW_W1] + (size_t)l * 1024 * 64;
    const float* a1 = p.in[I_RW_A1] + (size_t)l * 1024 * 64;
    const float* g1 = p.in[I_RW_G1] + (size_t)l * 1024 * 128;
    const float* v1 = p.in[I_RW_V1] + (size_t)(l > 0 ? l - 1 : 0) * 1024 * 32;
    const float* muw = p.in[I_RW_MU_WAG] + (size_t)l * 3 * 1024;
    const float* muv = p.in[I_RW_MU_V] + (size_t)(l > 0 ? l - 1 : 0) * 1024;
    transpose_job(p.Lora1, 320, 2048, [&](int n, int k) {
      int kk = k & 1023; bool hi = k >= 1024;
      float w, mu;
      if (n < 64) { w = w1[kk * 64 + n]; mu = muw[kk]; }
      else if (n < 128) { w = a1[kk * 64 + n - 64]; mu = muw[1024 + kk]; }
      else if (n < 256) { w = g1[kk * 128 + n - 128]; mu = muw[2048 + kk]; }
      else if (n < 288 && l > 0) { w = v1[kk * 32 + n - 256]; mu = muv[kk]; }
      else { w = 0.f; mu = 0.f; }
      return hi ? mu * w : (1.f - mu) * w;
    }, smf, base);
    const float* w2 = p.in[I_RW_W2] + (size_t)l * 64 * 512;
    const float* a2 = p.in[I_RW_A2] + (size_t)l * 64 * 512;
    const float* g2 = p.in[I_RW_G2] + (size_t)l * 128 * 512;
    const float* v2 = p.in[I_RW_V2] + (size_t)(l > 0 ? l - 1 : 0) * 32 * 512;
    transpose_job(p.W2T, 512, 64, [&](int n, int k) { return w2[k * 512 + n]; }, smf, base);
    transpose_job(p.A2T, 512, 64, [&](int n, int k) { return a2[k * 512 + n]; }, smf, base);
    transpose_job(p.G2T, 512, 128, [&](int n, int k) { return g2[k * 512 + n]; }, smf, base);
    transpose_job(p.V2T, 512, 64, [&](int n, int k) { return (k < 32 && l > 0) ? v2[k * 512 + n] : 0.f; }, smf, base);
  }
  {
    const float* wg = p.in[I_S5_W_GLU] + (size_t)l * 512 * 1024;
    transpose_job(p.GluT, 1024, 512, [&](int n, int k) {
      int j = interleave_col(n); int col = ((n >> 5) & 1) ? 512 + j : j;
      return wg[(size_t)k * 1024 + col];
    }, smf, base);
  }
  for (int nb = 0; nb < 4; nb++) {
    const float* wb = p.in[I_W_BRANCH] + ((size_t)l * 4 + nb) * 512 * 1024;
    transpose_job(p.BranchT + (size_t)nb * 1024 * 512, 1024, 512, [&](int n, int k) { return wb[(size_t)k * 1024 + n]; }, smf, base);
  }
  {
    const float* wo = p.in[I_W_OUT] + (size_t)l * 1024 * 1024;
    transpose_job(p.WoutT, 1024, 1024, [&](int n, int k) { return wo[(size_t)k * 1024 + n]; }, smf, base);
  }
  {
    const int gt = blockIdx.x * 256 + tidx(), gs = gridDim.x * 256;
    for (int it = gt; it < 2048; it += gs) {
      int g = it >> 6;
      float lr = p.in[I_S5_LAM_RE][l * 2048 + it], li = p.in[I_S5_LAM_IM][l * 2048 + it];
      float dt = expf(p.in[I_S5_LOG_DT][l * 32 + g]);
      float mag = expf(lr * dt);
      float sn, cs; sincosf(li * dt, &sn, &cs);
      float abr = mag * cs, abi = mag * sn;
      float nr = abr - 1.f, den = lr * lr + li * li;
      float fr = (nr * lr + abi * li) / den, fi = (abi * lr - nr * li) / den;
      p.s5A[it * 2] = abr; p.s5A[it * 2 + 1] = abi;
      float pr = abr, pi = abi;
      for (int s = 0; s < 7; s++) { float t = pr * pr - pi * pi; pi = 2.f * pr * pi; pr = t; }
      p.s5AL[it * 2] = pr; p.s5AL[it * 2 + 1] = pi;
      const float* br = p.in[I_S5_B_RE] + ((size_t)l * 2048 + it) * 16;
      const float* bi = p.in[I_S5_B_IM] + ((size_t)l * 2048 + it) * 16;
      for (int c = 0; c < 16; c++) {
        p.s5BB[it * 32 + c] = fr * br[c] - fi * bi[c];
        p.s5BB[it * 32 + 16 + c] = fr * bi[c] + fi * br[c];
      }
    }
    if (l == 0) {
      for (int it = gt; it < SEQ * 32; it += gs) {
        int pos = it >> 5, i = it & 31;
        float inv = (float)exp(-((double)i / 32.0) * 9.210340371976184);
        float ang = (float)pos * inv;
        double a = (double)ang;
        a -= 6.283185307179586 * rint(a * 0.15915494309189535);
        float sn, cs; sincosf((float)a, &sn, &cs);
        p.ropeC[it] = cs; p.ropeS[it] = sn;
      }
    }
  }
}

DI void rmsnorm_rows(const float* X, const float* gamma, bf16_t* outb, float* outf) {
  const int lane = tidx() & 63, wave = tidx() >> 6;
  for (int row = blockIdx.x * 4 + wave; row < TOK; row += gridDim.x * 4) {
    const float4* xr = (const float4*)(X + (size_t)row * DM);
    float4 v[4]; float ss = 0.f;
#pragma unroll
    for (int i = 0; i < 4; i++) { v[i] = xr[lane + 64 * i]; ss += v[i].x * v[i].x + v[i].y * v[i].y + v[i].z * v[i].z + v[i].w * v[i].w; }
    ss = wave_sum(ss);
    float rs = rsqrtf(ss * (1.f / DM) + 1e-6f);
#pragma unroll
    for (int i = 0; i < 4; i++) {
      float4 g = ((const float4*)gamma)[lane + 64 * i];
      float o0 = v[i].x * rs * g.x, o1 = v[i].y * rs * g.y, o2 = v[i].z * rs * g.z, o3 = v[i].w * rs * g.w;
      if (outb) {
        uint2 pk; pk.x = (unsigned)f2bf(o0) | ((unsigned)f2bf(o1) << 16); pk.y = (unsigned)f2bf(o2) | ((unsigned)f2bf(o3) << 16);
        *(uint2*)(outb + (size_t)row * DM + (lane + 64 * i) * 4) = pk;
      } else {
        ((float4*)(outf + (size_t)row * DM))[lane + 64 * i] = make_float4(o0, o1, o2, o3);
      }
    }
  }
}

DI void phase_gemm_qkv(const Params& p, bf16_t* sm) {
  bf16_t* qkv = (bf16_t*)p.TR;
  EPI_VARS
  XT4_LOOP(12, 0) {
    int mt_, nt_; xt4_decode(pos_, 12, mt_, nt_);
    const int row0 = mt_ * 256, n0 = nt_ * 128;
    f32x16 acc[4][2]; zero_acc4(acc);
    gemm_acc4(acc, p.h, 1024, row0, p.Wqkv, 1024, n0, 1024, sm);
#pragma unroll
    for (int mi = 0; mi < 4; mi++)
#pragma unroll
      for (int i = 0; i < 16; i++) {
        const int row = EPI_ROW4(mi, i);
        const int col = n0 + ewn * 64 + er;
        float x1 = acc[mi][0][i], x2 = acc[mi][1][i];
        if (n0 < 1024) {
          int pos = row & (SEQ - 1);
          float c = p.ropeC[pos * 32 + er], s = p.ropeS[pos * 32 + er];
          float o1 = x1 * c - x2 * s, o2 = x2 * c + x1 * s;
          if (n0 < 512) { o1 *= 0.125f; o2 *= 0.125f; }
          x1 = o1; x2 = o2;
        }
        qkv[(size_t)row * 1536 + col] = f2bf(x1);
        qkv[(size_t)row * 1536 + col + 32] = f2bf(x2);
      }
  }
}

DI void phase_gemm_plain(const bf16_t* A, int K, const bf16_t* Bt, int ntn, bf16_t* d0, bf16_t* d1, int nsplit, int ldd, bf16_t* sm, int& base) {
  EPI_VARS
  const int ntiles = 16 * ntn;
  XT4_LOOP(ntn, base) {
    int mt_, nt_; xt4_decode(pos_, ntn, mt_, nt_);
    const int row0 = mt_ * 256, n0 = nt_ * 128;
    f32x16 acc[4][2]; zero_acc4(acc);
    gemm_acc4(acc, A, K, row0, Bt, K, n0, K, sm);
    bf16_t* d = (n0 < nsplit) ? d0 : d1;
    const int cb = (n0 < nsplit) ? n0 : n0 - nsplit;
#pragma unroll
    for (int mi = 0; mi < 4; mi++)
#pragma unroll
      for (int ni = 0; ni < 2; ni++)
#pragma unroll
        for (int i = 0; i < 16; i++) {
          const int row = EPI_ROW4(mi, i);
          d[(size_t)row * ldd + cb + ewn * 64 + ni * 32 + er] = f2bf(acc[mi][ni][i]);
        }
  }
  base += ntiles;
}

DI void phase_lora1(const Params& p, bf16_t* lo1, bf16_t* sm, int& base) {
  EPI_VARS
  const int ntiles = 32 * 5;
  XT_LOOP(5, base) {
    int mt_, nt_; xt_decode(pos_, 5, mt_, nt_);
    const int row0 = mt_ * 128, n0 = nt_ * 64;
    f32x16 acc[2][1]; zero_acc<1>(acc);
    gemm_acc<1, 1>(acc, p.h, 1024, row0, p.Lora1, 2048, n0, 2048, sm);
#pragma unroll
    for (int mi = 0; mi < 2; mi++)
#pragma unroll
      for (int i = 0; i < 16; i++) {
        const int row = EPI_ROW(mi, i);
        const int col = n0 + ewn * 32 + er;
        float x = acc[mi][0][i];
        if (col < 64) x = tanhf_(x);
        else if (col >= 128 && col < 256) x = sigmoidf_(x);
        lo1[(size_t)row * 320 + col] = f2bf(x);
      }
  }
  base += ntiles;
}

template <int KIND>
DI void lora2_tile(const Params& p, int l, const bf16_t* lo1, bf16_t* lo2, const bf16_t* rkv, bf16_t* sm, int row0, int n0) {
  EPI_VARS
  const float* w0 = p.in[I_RW_W0] + l * 512;
  const float* a0 = p.in[I_RW_A0] + l * 512;
  const float* v0 = p.in[I_RW_V0] + (l > 0 ? l - 1 : 0) * 512;
  const float* muv = p.in[I_RW_MU_RKV] + (size_t)l * 3 * 512 + 1024;
  f32x16 acc[2][2]; zero_acc<2>(acc);
  const bf16_t* Bt = (KIND == 0) ? p.W2T : (KIND == 1) ? p.A2T : (KIND == 2) ? p.G2T : p.V2T;
  const int K = (KIND == 2) ? 128 : 64;
  const int aoff = (KIND == 0) ? 0 : (KIND == 1) ? 64 : (KIND == 2) ? 128 : 256;
  gemm_acc<2, 0>(acc, lo1 + aoff, 320, row0, Bt, K, n0, K, sm);
#pragma unroll
  for (int mi = 0; mi < 2; mi++)
#pragma unroll
    for (int ni = 0; ni < 2; ni++) {
#pragma unroll
      for (int i = 0; i < 16; i++) {
        const int row = EPI_ROW(mi, i);
        const int col = n0 + ewn * 64 + ni * 32 + er;
        const unsigned o = (unsigned)row * 512u + (unsigned)col;
        float x = acc[mi][ni][i];
        if (KIND == 0) {
          float wl = -softplusf_(-(w0[col] + x)) - 0.5f;
          lo2[o] = f2bf(__expf(wl));
        } else if (KIND == 1) {
          lo2[(size_t)TOK * 512 + o] = f2bf(sigmoidf_(a0[col] + x));
        } else if (KIND == 2) {
          lo2[(size_t)2 * TOK * 512 + o] = f2bf(x);
        } else {
          float vg = sigmoidf_(v0[col] + x);
          const unsigned ro = (unsigned)row * 1536u + 1024u + (unsigned)col;
          float vc = bf2f(rkv[ro]);
          float vp = (row & (SEQ - 1)) ? bf2f(rkv[ro - 1536u]) : 0.f;
          float vl = vc + (vp - vc) * muv[col];
          float vf = bf2f(p.vbuf[o]);
          p.vbuf[o] = f2bf(vl + (vf - vl) * vg);
        }
      }
      asm volatile("" ::: "memory");
    }
}

DI void phase_lora2(const Params& p, int l, const bf16_t* lo1, bf16_t* lo2, const bf16_t* rkv, bf16_t* sm, int& base) {
  const int nk = (l > 0) ? 4 : 3;
  const int ntiles = 32 * 4 * nk;
  XT_LOOP(4 * nk, base) {
    int mt_, nt_; xt_decode(pos_, 4 * nk, mt_, nt_);
    const int kind = nt_ % nk;
    const int row0 = mt_ * 128, n0 = (nt_ / nk) * 128;
    if (kind == 0) lora2_tile<0>(p, l, lo1, lo2, rkv, sm, row0, n0);
    else if (kind == 1) lora2_tile<1>(p, l, lo1, lo2, rkv, sm, row0, n0);
    else if (kind == 2) lora2_tile<2>(p, l, lo1, lo2, rkv, sm, row0, n0);
    else lora2_tile<3>(p, l, lo1, lo2, rkv, sm, row0, n0);
  }
  base += ntiles;
}

DI void phase_vlerp(const Params& p, int l, const bf16_t* rkv) {
  const float* muv = p.in[I_RW_MU_RKV] + (size_t)l * 3 * 512 + 1024;
  const size_t n = (size_t)TOK * 512;
  for (size_t e = (size_t)blockIdx.x * 256 + tidx(); e < n; e += (size_t)gridDim.x * 256) {
    int row = (int)(e >> 9), col = (int)(e & 511);
    float vc = bf2f(rkv[(size_t)row * 1536 + 1024 + col]);
    float vp = (row & (SEQ - 1)) ? bf2f(rkv[(size_t)(row - 1) * 1536 + 1024 + col]) : 0.f;
    p.vbuf[e] = f2bf(vc + (vp - vc) * muv[col]);
  }
}

DI void phase_glu(const Params& p, int l, const bf16_t* ybpre, bf16_t* sm, int& base) {
  EPI_VARS
  const float* bg = p.in[I_S5_B_GLU] + l * 1024;
  const int ntiles = 16 * 8;
  XT4_LOOP(8, base) {
    int mt_, tn; xt4_decode(pos_, 8, mt_, tn);
    const int row0 = mt_ * 256;
    f32x16 acc[4][2]; zero_acc4(acc);
    gemm_acc4(acc, ybpre, 512, row0, p.GluT, 512, tn * 128, 512, sm);
#pragma unroll
    for (int mi = 0; mi < 4; mi++)
#pragma unroll
      for (int i = 0; i < 16; i++) {
        const int row = EPI_ROW4(mi, i);
        const int j = tn * 64 + ewn * 32 + er;
        float val = acc[mi][0][i] + bg[j], gate = acc[mi][1][i] + bg[512 + j];
        p.yb[(size_t)row * 512 + j] = f2bf(val * sigmoidf_(gate));
      }
  }
  base += ntiles;
}

DI void phase_merge(const Params& p, bf16_t* merged, bf16_t* sm) {
  EPI_VARS
  XT_LOOP(8, 0) {
    int mt_, nt_; xt_decode(pos_, 8, mt_, nt_);
    const int row0 = mt_ * 128, n0 = nt_ * 128;
    unsigned mgp[2][2][8];
#pragma unroll
    for (int mi = 0; mi < 2; mi++)
#pragma unroll
      for (int ni = 0; ni < 2; ni++)
#pragma unroll
        for (int q = 0; q < 8; q++) mgp[mi][ni][q] = 0u;
#pragma unroll 1
    for (int nb = 0; nb < 4; nb++) {
      const bf16_t* y = (nb == 0) ? p.ya : (nb == 1) ? p.yb : (nb == 2) ? p.yc : p.yd;
      unsigned zp[2][2][8];
      {
        f32x16 az[2][2]; zero_acc<2>(az);
        gemm_acc<2, 0, 1>(az, y, 512, row0, p.BranchT + (size_t)nb * 1024 * 512, 512, n0, 512, sm);
#pragma unroll
        for (int mi = 0; mi < 2; mi++)
#pragma unroll
          for (int ni = 0; ni < 2; ni++)
#pragma unroll
            for (int q = 0; q < 8; q++)
              zp[mi][ni][q] = (unsigned)f2bf(az[mi][ni][2 * q]) | ((unsigned)f2bf(az[mi][ni][2 * q + 1]) << 16);
      }
      f32x16 ag[2][2]; zero_acc<2>(ag);
      gemm_acc<2, 0, 1>(ag, p.h, 1024, row0, p.Wgate + (size_t)nb * 1024 * 1024, 1024, n0, 1024, sm);
#pragma unroll
      for (int mi = 0; mi < 2; mi++)
#pragma unroll
        for (int ni = 0; ni < 2; ni++)
#pragma unroll
          for (int q = 0; q < 8; q++) {
            const unsigned z = zp[mi][ni][q], m = mgp[mi][ni][q];
            const float m0 = __uint_as_float(m << 16) + sigmoidf_(ag[mi][ni][2 * q]) * __uint_as_float(z << 16);
            const float m1 = __uint_as_float(m & 0xffff0000u) + sigmoidf_(ag[mi][ni][2 * q + 1]) * __uint_as_float(z & 0xffff0000u);
            mgp[mi][ni][q] = (unsigned)f2bf(m0) | ((unsigned)f2bf(m1) << 16);
          }
    }
#pragma unroll
    for (int mi = 0; mi < 2; mi++)
#pragma unroll
      for (int ni = 0; ni < 2; ni++)
#pragma unroll
        for (int q = 0; q < 8; q++) {
          const int r0 = EPI_ROW(mi, 2 * q), r1 = EPI_ROW(mi, 2 * q + 1);
          const int col = n0 + ewn * 64 + ni * 32 + er;
          merged[(size_t)r0 * 1024 + col] = (bf16_t)(mgp[mi][ni][q] & 0xffffu);
          merged[(size_t)r1 * 1024 + col] = (bf16_t)(mgp[mi][ni][q] >> 16);
        }
  }
}

DI void phase_gemm_resid(const bf16_t* A, int K, const bf16_t* Bt, const float* Xin, float* Xout, bf16_t* sm) {
  EPI_VARS
  XT4_LOOP(8, 0) {
    int mt_, nt_; xt4_decode(pos_, 8, mt_, nt_);
    const int row0 = mt_ * 256, n0 = nt_ * 128;
    f32x16 acc[4][2]; zero_acc4(acc);
    gemm_acc4(acc, A, K, row0, Bt, K, n0, K, sm);
    float xin[2][16];
#define RESID_LOAD(G)                                                                                         \
    {                                                                                                         \
      unsigned ob = (unsigned)(row0 + ewm * 128 + ((G) >> 1) * 32 + 4 * eh) * 1024u +                         \
                    (unsigned)(n0 + ewn * 64 + ((G) & 1) * 32 + er);                                          \
      asm volatile("" : "+v"(ob));                                                                            \
      _Pragma("unroll") for (int i = 0; i < 16; i++)                                                          \
        xin[(G) & 1][i] = Xin[ob + (unsigned)(((i & 3) + 8 * (i >> 2)) * 1024)];                              \
    }
    RESID_LOAD(0)
#pragma unroll
    for (int g = 0; g < 8; g++) {
      if (g + 1 < 8) RESID_LOAD(g + 1)
      asm volatile("" ::: "memory");
      unsigned ob = (unsigned)(row0 + ewm * 128 + (g >> 1) * 32 + 4 * eh) * 1024u + (unsigned)(n0 + ewn * 64 + (g & 1) * 32 + er);
      asm volatile("" : "+v"(ob));
#pragma unroll
      for (int i = 0; i < 16; i++)
        Xout[ob + (unsigned)(((i & 3) + 8 * (i >> 2)) * 1024)] = xin[g & 1][i] + acc[g >> 1][g & 1][i];
      asm volatile("" ::: "memory");
    }
#undef RESID_LOAD
  }
}

DI void phase_ffn_up(const Params& p, bf16_t* ffh, bf16_t* sm) {
  EPI_VARS
  XT4_LOOP(44, 0) {
    int mt_, tn; xt4_decode(pos_, 44, mt_, tn);
    const int row0 = mt_ * 256;
    f32x16 acc[4][2]; zero_acc4(acc);
    gemm_acc4(acc, p.h, 1024, row0, p.FfnGU, 1024, tn * 128, 1024, sm);
#pragma unroll
    for (int mi = 0; mi < 4; mi++)
#pragma unroll
      for (int i = 0; i < 16; i++) {
        const int row = EPI_ROW4(mi, i);
        const int j = tn * 64 + ewn * 32 + er;
        float g = acc[mi][0][i], u = acc[mi][1][i];
        ffh[(size_t)row * DFF + j] = f2bf(g * sigmoidf_(g) * u);
      }
  }
}

constexpr int VTP = 260;
DI void phase_attention(const Params& p, bf16_t* sm) {
  const bf16_t* qkv = (const bf16_t*)p.TR;
  bf16_t* og = (bf16_t*)(p.TR + (size_t)TOK * 1536 * 2);
  bf16_t* Ks = sm;
  bf16_t* Vs = sm + 256 * LP;
  const int tid = tidx(), lane = tid & 63, w = tid >> 6;
  const int r = lane & 31, hh = lane >> 5;
  for (int item = blockIdx.x; item < 3 * 2048; item += gridDim.x) {
    const int g = item / 2048, rem = item % 2048;
    const int dsh = 2 * g, d = 1 << dsh;
    const int b = rem >> 10, head = (rem >> 7) & 7, qb = rem & 127;
    const int rho = qb & (d - 1), blk = qb >> dsh;
    {
      const int kj = tid;
      const int sub = blk * 128 - 128 + kj;
      uint4 kv[8], vv[8];
      if (sub >= 0) {
        const size_t tokk = (size_t)b * SEQ + (size_t)sub * d + rho;
        const uint4* kp = (const uint4*)(qkv + tokk * 1536 + 512 + head * 64);
        const uint4* vp = (const uint4*)(qkv + tokk * 1536 + 1024 + head * 64);
#pragma unroll
        for (int c = 0; c < 8; c++) { kv[c] = kp[c]; vv[c] = vp[c]; }
      } else {
#pragma unroll
        for (int c = 0; c < 8; c++) { kv[c] = make_uint4(0, 0, 0, 0); vv[c] = make_uint4(0, 0, 0, 0); }
      }
#pragma unroll
      for (int c = 0; c < 8; c++) {
        *(uint4*)(Ks + kj * LP + c * 8) = kv[c];
        *(uint4*)(Vs + kj * LP + c * 8) = vv[c];
      }
    }
    __syncthreads();
    const int qi = 32 * w + r;
    const size_t tokq = (size_t)b * SEQ + (size_t)(blk * 128 + qi) * d + rho;
    bf16x8 qf[4];
#pragma unroll
    for (int ks = 0; ks < 4; ks++) qf[ks] = *(const bf16x8*)(qkv + tokq * 1536 + head * 64 + ks * 16 + hh * 8);
    f32x16 O[2];
#pragma unroll
    for (int i = 0; i < 16; i++) { O[0][i] = 0.f; O[1][i] = 0.f; }
    float m = -1e30f, lsum = 0.f;
    int kt0 = w; if (blk == 0 && kt0 < 4) kt0 = 4;
    for (int kt = kt0; kt <= w + 4; kt++) {
      f32x16 s;
#pragma unroll
      for (int i = 0; i < 16; i++) s[i] = 0.f;
#pragma unroll
      for (int ks = 0; ks < 4; ks++) {
        bf16x8 kf = *(const bf16x8*)(Ks + (kt * 32 + r) * LP + ks * 16 + hh * 8);
        s = __builtin_amdgcn_mfma_f32_32x32x16_bf16(kf, qf[ks], s, 0, 0, 0);
      }
      float mloc = -1e30f;
      bool valid[16];
#pragma unroll
      for (int i = 0; i < 16; i++) {
        int kj = kt * 32 + (i & 3) + 8 * (i >> 2) + 4 * hh;
        int dist = qi + 128 - kj;
        valid[i] = (dist >= 0) && (dist <= 128) && (blk > 0 || kj >= 128);
        if (valid[i]) mloc = fmaxf(mloc, s[i]);
      }
      mloc = fmaxf(mloc, __shfl_xor(mloc, 32));
      float mnew = fmaxf(m, mloc);
      float alpha = __expf(m - mnew);
      float ps = 0.f;
      float pv[16];
#pragma unroll
      for (int i = 0; i < 16; i++) { pv[i] = valid[i] ? __expf(s[i] - mnew) : 0.f; ps += pv[i]; }
      ps += __shfl_xor(ps, 32);
      lsum = lsum * alpha + ps;
      m = mnew;
#pragma unroll
      for (int i = 0; i < 16; i++) { O[0][i] *= alpha; O[1][i] *= alpha; }
      bf16x8 pf[2];
#pragma unroll
      for (int s2 = 0; s2 < 2; s2++)
#pragma unroll
        for (int j = 0; j < 8; j++) pf[s2][j] = (short)f2bf(pv[8 * s2 + j]);
#pragma unroll
      for (int dt = 0; dt < 2; dt++)
#pragma unroll
        for (int s2 = 0; s2 < 2; s2++) {
          const int i16 = lane & 15, tq = i16 >> 2, tp = i16 & 3, tblk = (lane >> 4) & 1;
          const bf16_t* vb = Vs + (kt * 32 + 16 * s2 + 4 * hh + tq) * LP + dt * 32 + 16 * tblk + 4 * tp;
          s16x4 lo = __builtin_amdgcn_ds_read_tr16_b64_v4i16((__attribute__((address_space(3))) s16x4*)(vb));
          s16x4 hi = __builtin_amdgcn_ds_read_tr16_b64_v4i16((__attribute__((address_space(3))) s16x4*)(vb + 8 * LP));
          bf16x8 vf = __builtin_shufflevector(lo, hi, 0, 1, 2, 3, 4, 5, 6, 7);
          O[dt] = __builtin_amdgcn_mfma_f32_32x32x16_bf16(vf, pf[s2], O[dt], 0, 0, 0);
        }
    }
    const float inv = 1.f / lsum;
    bf16_t* od = og + (size_t)g * TOK * 512 + tokq * 512 + head * 64;
#pragma unroll
    for (int dt = 0; dt < 2; dt++)
#pragma unroll
      for (int gq = 0; gq < 4; gq++) {
        uint2 pk;
        pk.x = (unsigned)f2bf(O[dt][4 * gq] * inv) | ((unsigned)f2bf(O[dt][4 * gq + 1] * inv) << 16);
        pk.y = (unsigned)f2bf(O[dt][4 * gq + 2] * inv) | ((unsigned)f2bf(O[dt][4 * gq + 3] * inv) << 16);
        *(uint2*)(od + dt * 32 + 8 * gq + 4 * hh) = pk;
      }
    if (hh == 0) p.lse[(size_t)g * TOK * 8 + tokq * 8 + head] = m + __logf(lsum);
    __syncthreads();
  }
}

DI void phase_attn_combine(const Params& p) {
  const bf16_t* og = (const bf16_t*)(p.TR + (size_t)TOK * 1536 * 2);
  const size_t n = (size_t)TOK * 64;
  for (size_t e = (size_t)blockIdx.x * 256 + tidx(); e < n; e += (size_t)gridDim.x * 256) {
    const size_t tok = e >> 6; const int cg8 = (int)(e & 63); const int head = cg8 >> 3;
    float l0 = p.lse[tok * 8 + head], l1 = p.lse[(size_t)TOK * 8 + tok * 8 + head], l2 = p.lse[(size_t)2 * TOK * 8 + tok * 8 + head];
    float mx = fmaxf(l0, fmaxf(l1, l2));
    float w0 = __expf(l0 - mx), w1 = __expf(l1 - mx), w2 = __expf(l2 - mx);
    float inv = 1.f / (w0 + w1 + w2);
    w0 *= inv; w1 *= inv; w2 *= inv;
    uint4 a = *(const uint4*)(og + tok * 512 + cg8 * 8);
    uint4 bq = *(const uint4*)(og + (size_t)TOK * 512 + tok * 512 + cg8 * 8);
    uint4 c = *(const uint4*)(og + (size_t)2 * TOK * 512 + tok * 512 + cg8 * 8);
    unsigned aa[4] = {a.x, a.y, a.z, a.w}, bb[4] = {bq.x, bq.y, bq.z, bq.w}, cc[4] = {c.x, c.y, c.z, c.w}, oo[4];
#pragma unroll
    for (int q = 0; q < 4; q++) {
      float lo = w0 * bf2f((bf16_t)(aa[q] & 0xffff)) + w1 * bf2f((bf16_t)(bb[q] & 0xffff)) + w2 * bf2f((bf16_t)(cc[q] & 0xffff));
      float hi = w0 * bf2f((bf16_t)(aa[q] >> 16)) + w1 * bf2f((bf16_t)(bb[q] >> 16)) + w2 * bf2f((bf16_t)(cc[q] >> 16));
      oo[q] = (unsigned)f2bf(lo) | ((unsigned)f2bf(hi) << 16);
    }
    *(uint4*)(p.ya + tok * 512 + cg8 * 8) = make_uint4(oo[0], oo[1], oo[2], oo[3]);
  }
}

DI float gelu_tanh(float x) {
  float u = 0.7978845608028654f * (x + 0.044715f * x * x * x);
  return 0.5f * x * (1.f + tanhf_(u));
}

constexpr int XSP = 136;
template <bool PASS2>
DI void s5_item(const Params& p, int l, int item, int lane, const bf16_t* ubuf, bf16_t* ybpre, bf16_t* xs, float* bus) {
  const int b = item / (32 * NCH5), g = (item / NCH5) % 32, c = item % NCH5;
  const int gp = g * 64 + lane;
  const int r = lane & 31, hh = lane >> 5;
  const float ar = p.s5A[gp * 2], ai = p.s5A[gp * 2 + 1];
  bf16x8 bf_[4];
#pragma unroll
  for (int mt = 0; mt < 4; mt++) {
    const float* src = p.s5BB + (size_t)(g * 64 + 32 * (mt & 1) + r) * 32 + ((mt >> 1) ? 16 : 0) + 8 * hh;
#pragma unroll
    for (int j = 0; j < 8; j++) bf_[mt][j] = (short)f2bf(src[j]);
  }
  bf16x8 cf[8];
  if (PASS2) {
    const float* cr = p.in[I_S5_C_RE] + ((size_t)l * 32 + g) * 16 * 64;
    const float* ci = p.in[I_S5_C_IM] + ((size_t)l * 32 + g) * 16 * 64;
#pragma unroll
    for (int ks = 0; ks < 8; ks++)
#pragma unroll
      for (int j = 0; j < 8; j++) {
        const int k = 16 * ks + 8 * hh + j;
        float v = 0.f;
        if (r < 16) v = (ks < 4) ? cr[r * 64 + k] : -ci[r * 64 + (k - 64)];
        cf[ks][j] = (short)f2bf(v);
      }
  }
  float* st = p.s5st + ((size_t)((b * 32 + g) * NCH5 + c) * 64 + lane) * 2;
  float xr = 0.f, xi = 0.f;
  if (PASS2) { xr = st[0]; xi = st[1]; }
  const size_t tok0 = (size_t)b * SEQ + (size_t)c * LC5;
#pragma unroll 1
  for (int tb = 0; tb < LC5; tb += 32) {
    const bf16x8 uf = *(const bf16x8*)(ubuf + (tok0 + tb + r) * 512 + g * 16 + 8 * hh);
    f32x16 D[4];
#pragma unroll
    for (int mt = 0; mt < 4; mt++) {
#pragma unroll
      for (int i = 0; i < 16; i++) D[mt][i] = 0.f;
      D[mt] = __builtin_amdgcn_mfma_f32_32x32x16_bf16(bf_[mt], uf, D[mt], 0, 0, 0);
    }
#pragma unroll
    for (int half = 0; half < 2; half++) {
      __builtin_amdgcn_fence(__ATOMIC_RELEASE, "wavefront");
      __builtin_amdgcn_wave_barrier();
      if ((r >> 4) == half) {
#pragma unroll
        for (int mt = 0; mt < 4; mt++)
#pragma unroll
          for (int i = 0; i < 16; i++)
            bus[(32 * mt + (i & 3) + 8 * (i >> 2) + 4 * hh) * 17 + (r & 15)] = D[mt][i];
      }
      __builtin_amdgcn_fence(__ATOMIC_RELEASE, "wavefront");
      __builtin_amdgcn_wave_barrier();
      __builtin_amdgcn_fence(__ATOMIC_ACQUIRE, "wavefront");
#pragma unroll 4
      for (int t = 0; t < 16; t++) {
        const float bur = bus[lane * 17 + t], bui = bus[(64 + lane) * 17 + t];
        const float nxr = ar * xr - ai * xi + bur, nxi = ar * xi + ai * xr + bui;
        xr = nxr; xi = nxi;
        if (PASS2) {
          xs[(half * 16 + t) * XSP + lane] = f2bf(xr);
          xs[(half * 16 + t) * XSP + 64 + lane] = f2bf(xi);
        }
      }
    }
    if (PASS2) {
      __builtin_amdgcn_fence(__ATOMIC_RELEASE, "wavefront");
      __builtin_amdgcn_wave_barrier();
      __builtin_amdgcn_fence(__ATOMIC_ACQUIRE, "wavefront");
      f32x16 acc;
#pragma unroll
      for (int i = 0; i < 16; i++) acc[i] = 0.f;
#pragma unroll
      for (int ks = 0; ks < 8; ks++) {
        const bf16x8 xf = *(const bf16x8*)(xs + r * XSP + ks * 16 + hh * 8);
        acc = __builtin_amdgcn_mfma_f32_32x32x16_bf16(cf[ks], xf, acc, 0, 0, 0);
      }
      const size_t tok = tok0 + tb + r;
#pragma unroll
      for (int q = 0; q < 2; q++) {
        const int c0 = 8 * q + 4 * hh;
        const uint2 uu = *(const uint2*)(ubuf + tok * 512 + g * 16 + c0);
        const float4 dd = *(const float4*)(p.in[I_S5_D] + l * 512 + g * 16 + c0);
        const float u0 = bf2f((bf16_t)(uu.x & 0xffff)), u1 = bf2f((bf16_t)(uu.x >> 16));
        const float u2 = bf2f((bf16_t)(uu.y & 0xffff)), u3 = bf2f((bf16_t)(uu.y >> 16));
        const float o0 = gelu_tanh(acc[4 * q + 0] + dd.x * u0), o1 = gelu_tanh(acc[4 * q + 1] + dd.y * u1);
        const float o2 = gelu_tanh(acc[4 * q + 2] + dd.z * u2), o3 = gelu_tanh(acc[4 * q + 3] + dd.w * u3);
        uint2 pk;
        pk.x = (unsigned)f2bf(o0) | ((unsigned)f2bf(o1) << 16);
        pk.y = (unsigned)f2bf(o2) | ((unsigned)f2bf(o3) << 16);
        *(uint2*)(ybpre + tok * 512 + g * 16 + c0) = pk;
      }
    }
  }
  if (!PASS2) { st[0] = xr; st[1] = xi; }
}

DI void s5_carry(const Params& p) {
  const int gt = blockIdx.x * 256 + tidx();
  if (gt < 4096) {
    const int bg = gt >> 6, lane = gt & 63; const int g = bg & 31;
    const float alr = p.s5AL[(g * 64 + lane) * 2], ali = p.s5AL[(g * 64 + lane) * 2 + 1];
    float xr = 0.f, xi = 0.f;
    float2* st = (float2*)(p.s5st + ((size_t)bg * NCH5 * 64 + lane) * 2);
#pragma unroll 1
    for (int c0 = 0; c0 < NCH5; c0 += 8) {
      float2 e[8];
#pragma unroll
      for (int q = 0; q < 8; q++) e[q] = st[(size_t)(c0 + q) * 64];
#pragma unroll
      for (int q = 0; q < 8; q++) {
        st[(size_t)(c0 + q) * 64] = make_float2(xr, xi);
        float nr = alr * xr - ali * xi + e[q].x, ni = alr * xi + ali * xr + e[q].y;
        xr = nr; xi = ni;
      }
    }
  }
}

template <bool PASS2>
DI void lru_item(const Params& p, int l, int item, int lane, const bf16_t* xl, float* wxs) {
  const int b = item / (8 * NCHL), blk = (item / NCHL) % 8, c = item % NCHL;
  const int ch = blk * 64 + lane;
  unsigned wpa[32], wpx[32];
  {
    const float* pa = p.in[I_LRU_W_A] + ((size_t)l * 8 + blk) * 4096;
    const float* px = p.in[I_LRU_W_X] + ((size_t)l * 8 + blk) * 4096;
    int lo_ = lane; asm volatile("" : "+v"(lo_));
#pragma unroll
    for (int m = 0; m < 32; m++) {
      wpa[m] = (unsigned)f2bf(pa[(2 * m) * 64 + lo_]) | ((unsigned)f2bf(pa[(2 * m + 1) * 64 + lo_]) << 16);
      wpx[m] = (unsigned)f2bf(px[(2 * m) * 64 + lo_]) | ((unsigned)f2bf(px[(2 * m + 1) * 64 + lo_]) << 16);
      if ((m & 7) == 7) asm volatile("" ::: "memory");
    }
  }
  const float* cw = p.in[I_LRU_CONV_W] + (size_t)l * 4 * 512;
  const float cw0 = cw[ch], cw1 = cw[512 + ch], cw2 = cw[1024 + ch], cw3 = cw[1536 + ch];
  const float cb = p.in[I_LRU_CONV_B][l * 512 + ch];
  const float ba = p.in[I_LRU_B_A][l * 512 + ch], bx = p.in[I_LRU_B_X][l * 512 + ch];
  const float sp = softplusf_(-p.in[I_LRU_LAM][l * 512 + ch]);
  const size_t tok0 = (size_t)b * SEQ + (size_t)c * LCL;
  float x1 = 0.f, x2 = 0.f, x3 = 0.f;
  if (c > 0) {
    x1 = bf2f(xl[(tok0 - 1) * 512 + ch]); x2 = bf2f(xl[(tok0 - 2) * 512 + ch]); x3 = bf2f(xl[(tok0 - 3) * 512 + ch]);
  }
  float* st = p.lrust + ((size_t)(b * 512 + ch) * NCHL + c) * 2;
  float hs = PASS2 ? st[1] : 0.f;
  float aprod = 1.f;
  float xn = bf2f(xl[tok0 * 512 + ch]);
#pragma unroll 1
  for (int t = 0; t < LCL; t++) {
    const float x0 = xn;
    if (t + 1 < LCL) xn = bf2f(xl[(tok0 + t + 1) * 512 + ch]);
    const float xc = cw3 * x0 + cw2 * x1 + cw1 * x2 + cw0 * x3 + cb;
    x3 = x2; x2 = x1; x1 = x0;
    float ra0 = ba, ra1 = 0.f, rx0 = bx, rx1 = 0.f;
    const unsigned xb16 = (unsigned)f2bf(xc);
    const unsigned xnb = (unsigned)__shfl_xor((int)xb16, 1);
    const unsigned xpk = xb16 | (xnb << 16);
#pragma unroll
    for (int m = 0; m < 32; m += 2) {
      const bf2_t xa = __builtin_bit_cast(bf2_t, (unsigned)__builtin_amdgcn_readlane((int)xpk, 2 * m));
      const bf2_t xb = __builtin_bit_cast(bf2_t, (unsigned)__builtin_amdgcn_readlane((int)xpk, 2 * m + 2));
      ra0 = __builtin_amdgcn_fdot2_f32_bf16(xa, __builtin_bit_cast(bf2_t, wpa[m]), ra0, false);
      rx0 = __builtin_amdgcn_fdot2_f32_bf16(xa, __builtin_bit_cast(bf2_t, wpx[m]), rx0, false);
      ra1 = __builtin_amdgcn_fdot2_f32_bf16(xb, __builtin_bit_cast(bf2_t, wpa[m + 1]), ra1, false);
      rx1 = __builtin_amdgcn_fdot2_f32_bf16(xb, __builtin_bit_cast(bf2_t, wpx[m + 1]), rx1, false);
    }
    const float rg = sigmoidf_(ra0 + ra1), ig = sigmoidf_(rx0 + rx1);
    const float la = -8.f * rg * sp;
    const float a = __expf(la);
    const float inp = sqrtf(fmaxf(1.f - a * a, 0.f)) * (ig * xc);
    hs = a * hs + inp;
    if (PASS2) p.yd[(tok0 + t) * 512 + ch] = f2bf(hs);
    else aprod *= a;
  }
  if (!PASS2) { st[0] = aprod; st[1] = hs; }
}

DI void lru_carry(const Params& p) {
  const int gt = blockIdx.x * 256 + tidx();
  if (gt >= 4096 && gt < 4096 + 1024) {
    const int bc = gt - 4096;
    float2* st = (float2*)(p.lrust + (size_t)bc * NCHL * 2);
    float hcur = 0.f;
#pragma unroll 1
    for (int c0 = 0; c0 < NCHL; c0 += 8) {
      float2 e[8];
#pragma unroll
      for (int q = 0; q < 8; q++) e[q] = st[c0 + q];
#pragma unroll
      for (int q = 0; q < 8; q++) {
        st[c0 + q] = make_float2(e[q].x, hcur);
        hcur = e[q].x * hcur + e[q].y;
      }
    }
  }
}

template <bool PASS2>
DI void rwkv_item(const Params& p, int l, int item, int lane, const bf16_t* rkv, const bf16_t* lo2, float* rwst) {
  const int b = item / (8 * NCHR), head = (item / NCHR) % 8, c = item % NCHR;
  const int ch = head * 64 + lane;
  const float mu_r = p.in[I_RW_MU_RKV][(size_t)l * 1536 + ch], mu_k = p.in[I_RW_MU_RKV][(size_t)l * 1536 + 512 + ch];
  const float kkw = p.in[I_RW_K_K][l * 512 + ch], kaw = p.in[I_RW_K_A][l * 512 + ch];
  const float rkw = p.in[I_RW_R_K][l * 512 + ch];
  const float gnw = p.in[I_RW_GN_W][l * 512 + ch], gnb = p.in[I_RW_GN_B][l * 512 + ch];
  const size_t tok0 = (size_t)b * SEQ + (size_t)c * LCR;
  float* stS = rwst + ((size_t)((b * 8 + head) * NCHR + c)) * 4096;
  float* stP = (float*)p.yc + ((size_t)((b * 8 + head) * NCHR + c)) * 4096;
  float S[64], P[64];
#pragma unroll
  for (int j = 0; j < 64; j++) { S[j] = 0.f; P[j] = (j == lane) ? 1.f : 0.f; }
  if (PASS2 && c > 0) {
    const float4* sp = (const float4*)(stS - 4096 + lane * 64);
#pragma unroll
    for (int j = 0; j < 16; j++) { float4 v = sp[j]; S[4 * j] = v.x; S[4 * j + 1] = v.y; S[4 * j + 2] = v.z; S[4 * j + 3] = v.w; }
  }
  float rp_prev = 0.f, kp_prev = 0.f;
  if (c > 0) { rp_prev = bf2f(rkv[(tok0 - 1) * 1536 + ch]); kp_prev = bf2f(rkv[(tok0 - 1) * 1536 + 512 + ch]); }
  const bf16_t* ewb = lo2; const bf16_t* ab = lo2 + (size_t)TOK * 512; const bf16_t* gb = lo2 + (size_t)2 * TOK * 512;
  struct Raw { bf16_t rp, kp, v, ew, a, g; };
  struct Der { float rr, wdec, kf, av, bv, v, gg; };
  auto load_raw = [&](size_t tk) __attribute__((always_inline)) {
    Raw x;
    x.rp = rkv[tk * 1536 + ch]; x.kp = rkv[tk * 1536 + 512 + ch]; x.v = p.vbuf[tk * 512 + ch];
    x.ew = ewb[tk * 512 + ch]; x.a = ab[tk * 512 + ch]; x.g = PASS2 ? gb[tk * 512 + ch] : (bf16_t)0;
    return x;
  };
  auto derive = [&](const Raw& x, float rpp, float kpp) __attribute__((always_inline)) {
    Der d;
    const float rp = bf2f(x.rp), kp = bf2f(x.kp), a = bf2f(x.a);
    d.rr = rp + (rpp - rp) * mu_r;
    const float k = kp + (kpp - kp) * mu_k;
    d.wdec = __expf(-bf2f(x.ew));
    float kkv = k * kkw;
    const float nrm = wave_sum(kkv * kkv);
    kkv *= rsqrtf(fmaxf(nrm, 1e-24f));
    d.kf = k * (1.f + (a - 1.f) * kaw);
    d.av = -kkv; d.bv = kkv * a;
    d.v = bf2f(x.v); d.gg = bf2f(x.g);
    return d;
  };
  Raw rawB = load_raw(tok0);
  Der cur = derive(rawB, rp_prev, kp_prev);
  float rpA = bf2f(rawB.rp), kpA = bf2f(rawB.kp);
  rawB = load_raw(tok0 + 1);
#pragma unroll 1
  for (int t = 0; t < LCR; t++) {
    Raw rawC = rawB;
    if (t + 2 < LCR) rawC = load_raw(tok0 + t + 2);
    Der nxt = cur;
    if (t + 1 < LCR) nxt = derive(rawB, rpA, kpA);
    const float rr = cur.rr, wdec = cur.wdec, kf = cur.kf, av = cur.av, bv = cur.bv, v = cur.v, gg = cur.gg;
    float sa0 = 0.f, sa1 = 0.f, pa0 = 0.f, pa1 = 0.f;
#pragma unroll
    for (int j = 0; j < 64; j += 2) {
      const float a0 = rl(av, j), a1 = rl(av, j + 1);
      sa0 += S[j] * a0; sa1 += S[j + 1] * a1;
      if (!PASS2) { pa0 += P[j] * a0; pa1 += P[j + 1] * a1; }
    }
    const float sa = sa0 + sa1, pa = pa0 + pa1;
    float y0 = 0.f, y1 = 0.f;
#pragma unroll
    for (int j = 0; j < 64; j += 2) {
      const float w0 = rl(wdec, j), b0 = rl(bv, j), k0 = rl(kf, j);
      const float w1 = rl(wdec, j + 1), b1 = rl(bv, j + 1), k1 = rl(kf, j + 1);
      S[j] = S[j] * w0 + sa * b0 + v * k0;
      S[j + 1] = S[j + 1] * w1 + sa * b1 + v * k1;
      if (!PASS2) {
        P[j] = P[j] * w0 + pa * b0;
        P[j + 1] = P[j + 1] * w1 + pa * b1;
      } else {
        y0 += S[j] * rl(rr, j); y1 += S[j + 1] * rl(rr, j + 1);
      }
    }
    if (PASS2) {
      const float y = y0 + y1;
      float s1 = y, s2 = y * y, s3 = rr * kf * rkw;
#pragma unroll
      for (int off = 32; off >= 1; off >>= 1) {
        const float t1 = __shfl_xor(s1, off), t2 = __shfl_xor(s2, off), t3 = __shfl_xor(s3, off);
        s1 += t1; s2 += t2; s3 += t3;
      }
      const float mean = s1 * (1.f / 64.f);
      const float var = fmaxf(s2 * (1.f / 64.f) - mean * mean, 0.f);
      const float yn = (y - mean) * rsqrtf(var + 64e-5f) * gnw + gnb;
      const float bs = s3;
      p.yc[(tok0 + t) * 512 + ch] = f2bf((yn + bs * v) * gg);
    }
    rpA = bf2f(rawB.rp); kpA = bf2f(rawB.kp); rawB = rawC; cur = nxt;
  }
  if (!PASS2) {
    float4* sp = (float4*)(stS + lane * 64);
    float4* pp = (float4*)(stP + lane * 64);
#pragma unroll
    for (int j = 0; j < 16; j++) {
      sp[j] = make_float4(S[4 * j], S[4 * j + 1], S[4 * j + 2], S[4 * j + 3]);
      pp[j] = make_float4(P[4 * j], P[4 * j + 1], P[4 * j + 2], P[4 * j + 3]);
    }
  }
}

DI void rwkv_carry(const Params& p, float* rwst) {
  const int lane = tidx() & 63, wave = tidx() >> 6;
  const int wsel = ((int)blockIdx.x < (int)(gridDim.x >> 1)) ? wave : wave - 2;
  if (wsel >= 0 && wsel < 2)
  for (int item = wsel * gridDim.x + blockIdx.x; item < 1024; item += gridDim.x * 2) {
    const int itu = __builtin_amdgcn_readfirstlane(item);
    const int bh = itu >> 6, i = itu & 63;
    float* stS = rwst + (size_t)bh * NCHR * 4096 + i * 64 + lane;
    const float* stP = (const float*)p.yc + (size_t)bh * NCHR * 4096 + lane;
    float v = 0.f;
    float pc[64], sc;
#pragma unroll
    for (int mm = 0; mm < 64; mm++) pc[mm] = stP[mm * 64];
    sc = stS[0];
#pragma unroll 1
    for (int c = 0; c < NCHR - 1; c++) {
      float pn[64], sn = 0.f;
      const bool more = (c + 2 < NCHR);
#pragma unroll
      for (int mm = 0; mm < 64; mm++) pn[mm] = more ? stP[(size_t)(c + 1) * 4096 + mm * 64] : 0.f;
      if (more) sn = stS[(size_t)(c + 1) * 4096];
      float acc0 = sc, acc1 = 0.f;
#pragma unroll
      for (int mm = 0; mm < 64; mm += 2) {
        acc0 += rl(v, mm) * pc[mm];
        acc1 += rl(v, mm + 1) * pc[mm + 1];
      }
      v = acc0 + acc1;
      stS[(size_t)c * 4096] = v;
#pragma unroll
      for (int mm = 0; mm < 64; mm++) pc[mm] = pn[mm];
      sc = sn;
    }
  }
}


#define XB_TMO      128
#define XB_XCNT(j)  (256  + 64 * (j))
#define XB_XSUB(j)  (1280 + 64 * (j))
#define XB_XGEN(j)  (2304 + 64 * (j))
#define XB_TOP      3328
#define XB_TOPGEN   3392
#define XCD_BAR_WORDS 3456
#define XB_SPIN_CAP (1u << 22)
#define LAS __attribute__((address_space(3)))
DI unsigned xb_ld(unsigned* p)              { return __hip_atomic_load(p, __ATOMIC_RELAXED, __HIP_MEMORY_SCOPE_AGENT); }
DI unsigned xb_add(unsigned* p, unsigned v) { return __hip_atomic_fetch_add(p, v, __ATOMIC_RELAXED, __HIP_MEMORY_SCOPE_AGENT); }
DI unsigned xb_xcc_id() { return (unsigned)__builtin_amdgcn_s_getreg((3 << 11) | 20) & 0xFu; }
#define XB_SPIN(cond, bar) do { unsigned _sp = 0; while (cond) { __builtin_amdgcn_s_sleep(1); \
    if ((++_sp & 255u) == 0u) { if (xb_ld(&(bar)[XB_TMO])) break; if (_sp > XB_SPIN_CAP) { atomicAdd(&(bar)[XB_TMO], 1u); break; } } } } while (0)
struct XcdBarrier { unsigned* bar; unsigned x; volatile LAS unsigned* st; };
DI XcdBarrier xcd_barrier_post(unsigned* bar, volatile LAS unsigned* st) {
  XcdBarrier b; b.bar = bar; b.x = xb_xcc_id(); b.st = st;
  if (__builtin_amdgcn_workitem_id_x() == 0) (void)xb_add(&bar[XB_XCNT(b.x)], 1u);
  return b;
}
DI void xcd_barrier_complete(unsigned* bar, unsigned x, unsigned& nloc, unsigned& nx) {
  const unsigned G = gridDim.x * gridDim.y * gridDim.z;
  unsigned sum, cnt, mine, sp = 0u;
  for (;;) {
    sum = 0u; cnt = 0u; mine = 0u;
#pragma unroll
    for (unsigned j = 0; j < 16; ++j) { const unsigned c = xb_ld(&bar[XB_XCNT(j)]); sum += c; cnt += (c > 0u) ? 1u : 0u; mine = (j == x) ? c : mine; }
    if (sum == G) break;
    __builtin_amdgcn_s_sleep(1);
    if ((++sp & 255u) == 0u) { if (xb_ld(&bar[XB_TMO])) break; if (sp > XB_SPIN_CAP) { atomicAdd(&bar[XB_TMO], 1u); break; } }
  }
  nloc = mine > 0u ? mine : 1u; nx = cnt > 0u ? cnt : 1u;
}
DI void xcd_barrier(const XcdBarrier& b) {
  asm volatile("s_waitcnt vmcnt(0)" ::: "memory");
  __syncthreads();
  if (__builtin_amdgcn_workitem_id_x() == 0) {
    unsigned* bar = b.bar;
    __builtin_amdgcn_s_waitcnt(0);
    unsigned nloc = b.st[0], nx = b.st[1];
    if (nloc == 0u) { xcd_barrier_complete(bar, b.x, nloc, nx); b.st[0] = nloc; b.st[1] = nx; }
    const unsigned old = xb_add(&bar[XB_XSUB(b.x)], 1u);
    const unsigned gen = old / nloc;
    if (old + 1u == (gen + 1u) * nloc) {
      __builtin_amdgcn_fence(__ATOMIC_RELEASE, "agent");
      asm volatile("s_waitcnt vmcnt(0)" ::: "memory");
      const unsigned og = xb_add(&bar[XB_TOP], 1u);
      const unsigned tg = og / nx;
      if (og + 1u == (tg + 1u) * nx) xb_add(&bar[XB_TOPGEN], 1u);
      else XB_SPIN(xb_ld(&bar[XB_TOPGEN]) == tg, bar);
      __builtin_amdgcn_fence(__ATOMIC_ACQUIRE, "agent");
      xb_add(&bar[XB_XGEN(b.x)], 1u);
      asm volatile("s_waitcnt vmcnt(0)" ::: "memory");
    } else {
      XB_SPIN(xb_ld(&bar[XB_XGEN(b.x)]) == gen, bar);
      __builtin_amdgcn_fence(__ATOMIC_ACQUIRE, "agent");
      asm volatile("s_waitcnt vmcnt(0)" ::: "memory");
    }
  }
  __syncthreads();
}

template <int Q>
DI void run_phase(const Params& p, int l, bf16_t* sm) {
  const int lane = tidx() & 63, wave = tidx() >> 6;
  char* TR = p.TR;
  const size_t MB = 1048576;
  bf16_t* ubuf = (bf16_t*)TR;
  bf16_t* xlbuf = (bf16_t*)(TR + 32 * MB);
  bf16_t* ybpre = (bf16_t*)(TR + 64 * MB);
  bf16_t* rkv = (bf16_t*)(TR + 96 * MB);
  bf16_t* lo1 = (bf16_t*)(TR + 192 * MB);
  float* rwst = (float*)(TR + 192 * MB);
  bf16_t* lo2 = (bf16_t*)TR;
  bf16_t* merged = (bf16_t*)TR;
  bf16_t* ffh = (bf16_t*)TR;
  const float* Xin = (l == 0) ? p.in[I_X] : p.X;
  if (Q == 0) { rmsnorm_rows(Xin, p.in[I_NORM_MIX] + l * DM, p.h, nullptr); if (l == 0) phase_prep(p, 0, (float*)sm, 1); }
  if (Q == 2) phase_gemm_qkv(p, sm);
  if (Q == 3) phase_attention(p, sm);
  if (Q == 5) { phase_attn_combine(p); int base = 0; phase_gemm_plain(p.h, 1024, p.Wux, 8, ubuf, xlbuf, 512, 512, sm, base); }
  if (Q == 6) {
    for (int it = wave * gridDim.x + blockIdx.x; it < 16 * NCHL; it += gridDim.x * 4) lru_item<false>(p, l, __builtin_amdgcn_readfirstlane(it), lane, xlbuf, (float*)sm + wave * 4096);
    for (int it = first_item(16 * NCHL, wave * gridDim.x + blockIdx.x, gridDim.x * 4); it < 64 * NCH5; it += gridDim.x * 4)
      s5_item<false>(p, l, __builtin_amdgcn_readfirstlane(it), lane, ubuf, ybpre, sm + wave * (32 * XSP), (float*)((char*)sm + 34816) + wave * 2176);
  }
  if (Q == 7) { s5_carry(p); lru_carry(p); }
  if (Q == 8) {
    for (int it = wave * gridDim.x + blockIdx.x; it < 16 * NCHL; it += gridDim.x * 4) lru_item<true>(p, l, __builtin_amdgcn_readfirstlane(it), lane, xlbuf, (float*)sm + wave * 4096);
    for (int it = first_item(16 * NCHL, wave * gridDim.x + blockIdx.x, gridDim.x * 4); it < 64 * NCH5; it += gridDim.x * 4)
      s5_item<true>(p, l, __builtin_amdgcn_readfirstlane(it), lane, ubuf, ybpre, sm + wave * (32 * XSP), (float*)((char*)sm + 34816) + wave * 2176);
  }
  if (Q == 9) {
    int base = 0;
    phase_gemm_plain(p.h, 1024, p.Wrkv, 12, rkv, rkv, 1 << 30, 1536, sm, base);
    phase_lora1(p, lo1, sm, base);
    phase_glu(p, l, ybpre, sm, base);
  }
  if (Q == 10) {
    int base = 0;
    phase_lora2(p, l, lo1, lo2, rkv, sm, base);
    if (l == 0) phase_vlerp(p, l, rkv);
  }
  const int wsel = ((int)blockIdx.x < (int)(gridDim.x >> 1)) ? wave : wave - 2;
  if (Q == 11) {
    for (int it = wave * gridDim.x + blockIdx.x; it < 16 * NCHR; it += gridDim.x * 4) rwkv_item<false>(p, l, __builtin_amdgcn_readfirstlane(it), lane, rkv, lo2, rwst);
  }
  if (Q == 12) { rwkv_carry(p, rwst); phase_prep(p, l, (float*)sm, 2); }
  if (Q == 13) {
    for (int it = wave * gridDim.x + blockIdx.x; it < 16 * NCHR; it += gridDim.x * 4) rwkv_item<true>(p, l, __builtin_amdgcn_readfirstlane(it), lane, rkv, lo2, rwst);
  }
  if (Q == 14) phase_merge(p, merged, sm);
  if (Q == 15) phase_gemm_resid(merged, 1024, p.WoutT, Xin, p.X, sm);
  if (Q == 16) { rmsnorm_rows(p.X, p.in[I_NORM_FFN] + l * DM, p.h, nullptr); if (l == 0) phase_prep(p, 1, (float*)sm, 1); }
  if (Q == 17) phase_ffn_up(p, ffh, sm);
  if (Q == 18) phase_gemm_resid(ffh, DFF, p.FfnDown, p.X, p.X, sm);
  if (Q == 19) rmsnorm_rows(p.X, p.in[I_NORM_FINAL], nullptr, p.X);
}

#if MEGA
#define PH(Q) run_phase<Q>(p, l, (bf16_t*)smem_raw); xcd_barrier(xb);
__global__ void __launch_bounds__(256, 2) fwd_megakernel(KArgs k) {
  __shared__ __attribute__((aligned(16))) char smem_raw[SMEM_BYTES];
  __shared__ uint4 xb_words;
  cg::grid_group grid = cg::this_grid();
  const Params p = make_params(k);
  if (__builtin_amdgcn_workitem_id_x() == 0) xb_words = make_uint4(0u, 0u, 0u, 0u);
  __syncthreads();
  const XcdBarrier xb = xcd_barrier_post((unsigned*)(k.ws + O_bar), (volatile LAS unsigned*)&xb_words);
  {
    const int l = 0;
    run_phase<0>(p, l, (bf16_t*)smem_raw); grid.sync();
    PH(2) PH(3) PH(5) PH(6) PH(7) PH(8) PH(9) PH(10) PH(11) PH(12) PH(13) PH(14) PH(15) PH(16) PH(17) PH(18)
  }
  {
    const int l = 1;
    PH(0) PH(2) PH(3) PH(5) PH(6) PH(7) PH(8) PH(9) PH(10) PH(11) PH(12) PH(13) PH(14) PH(15) PH(16) PH(17) PH(18)
  }
  run_phase<19>(p, 1, (bf16_t*)smem_raw);
}
#else
template <int Q>
__global__ void __launch_bounds__(256, 2) fwd_phase_kernel(KArgs k, int l) {
  __shared__ __attribute__((aligned(16))) char smem_raw[SMEM_BYTES];
  const Params p = make_params(k);
  run_phase<Q>(p, l, (bf16_t*)smem_raw);
}
#endif

extern "C" void kernel_launch(void* const* d_in, const int* in_sizes, int n_in, void* d_out, int out_size,
                              void* d_ws, size_t ws_size, hipStream_t stream) {
  KArgs p;
  memset(&p, 0, sizeof(p));
  for (int i = 0; i < I_COUNT && i < n_in; i++) p.in[i] = (const float*)d_in[i];
  p.ws = (char*)d_ws;
  p.X = (float*)d_out;
  if (WS_NEED > ws_size) { fprintf(stderr, "workspace too small: need %zu have %zu\n", (size_t)WS_NEED, ws_size); return; }
#if MEGA
  static int grid_blocks = 0;
  if (!grid_blocks) {
    int dev = 0, cus = 0, per_cu = 0;
    hipGetDevice(&dev);
    hipDeviceGetAttribute(&cus, hipDeviceAttributeMultiprocessorCount, dev);
    hipOccupancyMaxActiveBlocksPerMultiprocessor(&per_cu, fwd_megakernel, 256, 0);
    if (per_cu > 2) per_cu = 2;
    grid_blocks = (cus * per_cu) & ~7;
  }
  hipMemsetAsync((char*)d_ws + O_bar, 0, 16384, stream);
  void* args[] = {&p};
  hipError_t e = hipLaunchCooperativeKernel((void*)fwd_megakernel, dim3(grid_blocks), dim3(256), args, 0, stream);
  if (e != hipSuccess) fprintf(stderr, "cooperative launch failed: %s (grid %d)\n", hipGetErrorString(e), grid_blocks);
#else
#define LP_(Q) fwd_phase_kernel<Q><<<512, 256, 0, stream>>>(p, l);
  for (int l = 0; l < 2; l++) {
    LP_(0) LP_(2) LP_(3) LP_(5) LP_(6) LP_(7) LP_(8) LP_(9) LP_(10) LP_(11) LP_(12) LP_(13) LP_(14) LP_(15) LP_(16) LP_(17) LP_(18)
  }
  fwd_phase_kernel<19><<<512, 256, 0, stream>>>(p, 1);
#endif
}
```

```cpp
#include <hip/hip_runtime.h>
#include <hip/hip_cooperative_groups.h>
#include <cstdio>
#include <cstring>
namespace cg = cooperative_groups;

#ifndef MEGA
#define MEGA 1
#endif

typedef unsigned short bf16_t;
typedef __attribute__((ext_vector_type(8))) short bf16x8;
typedef __attribute__((ext_vector_type(16))) float f32x16;
typedef __attribute__((ext_vector_type(4))) short s16x4;
typedef __attribute__((ext_vector_type(2))) __bf16 bf2_t;

#define DI __device__ __forceinline__

constexpr int SEQ = 16384;
constexpr int TOK = 32768;
constexpr int DM = 1024;
constexpr int NIN = 8192;
constexpr int DFF = 2816;
constexpr int LC5 = 128, NCH5 = SEQ / LC5;
constexpr int LCL = 128, NCHL = SEQ / LCL;
constexpr int LCR = 128, NCHR = SEQ / LCR;
constexpr int SMEM_BYTES = 73728;

enum {
  I_X = 0, I_NORM_MIX, I_W_IN, I_S5_LAM_RE, I_S5_LAM_IM, I_S5_LOG_DT, I_S5_B_RE, I_S5_B_IM, I_S5_C_RE, I_S5_C_IM,
  I_S5_D, I_S5_W_GLU, I_S5_B_GLU, I_RW_MU_RKV, I_RW_MU_WAG, I_RW_W0, I_RW_W1, I_RW_W2, I_RW_A0, I_RW_A1, I_RW_A2,
  I_RW_G1, I_RW_G2, I_RW_K_K, I_RW_K_A, I_RW_R_K, I_RW_GN_W, I_RW_GN_B, I_RW_MU_V, I_RW_V0, I_RW_V1, I_RW_V2,
  I_LRU_CONV_W, I_LRU_CONV_B, I_LRU_W_A, I_LRU_B_A, I_LRU_W_X, I_LRU_B_X, I_LRU_LAM, I_W_BRANCH, I_W_OUT,
  I_NORM_FFN, I_W_FFN_GATE, I_W_FFN_UP, I_W_FFN_DOWN, I_NORM_FINAL, I_COUNT
};

constexpr size_t al256(size_t x) { return (x + 255) & ~(size_t)255; }
constexpr size_t O_Wqkv = 0;
constexpr size_t O_Wux = O_Wqkv + al256((size_t)1536 * 1024 * 2);
constexpr size_t O_Wrkv = O_Wux + al256((size_t)1024 * 1024 * 2);
constexpr size_t O_Wgate = O_Wrkv + al256((size_t)1536 * 1024 * 2);
constexpr size_t O_Lora1 = O_Wgate + al256((size_t)4096 * 1024 * 2);
constexpr size_t O_W2T = O_Lora1 + al256((size_t)320 * 2048 * 2);
constexpr size_t O_A2T = O_W2T + al256((size_t)512 * 64 * 2);
constexpr size_t O_G2T = O_A2T + al256((size_t)512 * 64 * 2);
constexpr size_t O_V2T = O_G2T + al256((size_t)512 * 128 * 2);
constexpr size_t O_GluT = O_V2T + al256((size_t)512 * 64 * 2);
constexpr size_t O_BranchT = O_GluT + al256((size_t)1024 * 512 * 2);
constexpr size_t O_WoutT = O_BranchT + al256((size_t)4 * 1024 * 512 * 2);
constexpr size_t O_FfnGU = O_WoutT + al256((size_t)1024 * 1024 * 2);
constexpr size_t O_FfnDown = O_FfnGU + al256((size_t)2 * DFF * 1024 * 2);
constexpr size_t O_ropeC = O_FfnDown + al256((size_t)1024 * DFF * 2);
constexpr size_t O_ropeS = O_ropeC + al256((size_t)SEQ * 32 * 4);
constexpr size_t O_s5A = O_ropeS + al256((size_t)SEQ * 32 * 4);
constexpr size_t O_s5AL = O_s5A + al256(2048 * 2 * 4);
constexpr size_t O_s5BB = O_s5AL + al256(2048 * 2 * 4);
constexpr size_t O_s5st = O_s5BB + al256(2048 * 32 * 4);
constexpr size_t O_lrust = O_s5st + al256((size_t)64 * NCH5 * 64 * 2 * 4);
constexpr size_t O_lse = O_lrust + al256((size_t)1024 * NCHL * 2 * 4);
constexpr size_t O_vbuf = O_lse + al256((size_t)3 * TOK * 8 * 4);
constexpr size_t O_h = O_vbuf + al256((size_t)TOK * 512 * 2);
constexpr size_t O_ya = O_h + al256((size_t)TOK * 1024 * 2);
constexpr size_t O_yb = O_ya + al256((size_t)TOK * 512 * 2);
constexpr size_t O_yc = O_yb + al256((size_t)TOK * 512 * 2);
constexpr size_t O_yd = O_yc + al256((size_t)TOK * 512 * 2);
constexpr size_t O_TR = O_yd + al256((size_t)TOK * 512 * 2);
constexpr size_t O_bar = O_TR + (size_t)224 * 1048576;
constexpr size_t WS_NEED = O_bar + 16384;

struct KArgs {
  const float* in[46];
  char* ws;
  float* X;
};

struct Params {
  const float* const* in;
  bf16_t *Wqkv, *Wux, *Wrkv, *Wgate, *Lora1, *W2T, *A2T, *G2T, *V2T, *GluT, *BranchT, *WoutT, *FfnGU, *FfnDown;
  float *ropeC, *ropeS, *s5A, *s5AL, *s5BB, *s5st, *lrust, *lse;
  bf16_t *vbuf, *h, *ya, *yb, *yc, *yd;
  char* TR;
  float* X;
};

DI Params make_params(const KArgs& k) {
  Params p;
  p.in = k.in;
  char* ws = k.ws;
  p.Wqkv = (bf16_t*)(ws + O_Wqkv); p.Wux = (bf16_t*)(ws + O_Wux); p.Wrkv = (bf16_t*)(ws + O_Wrkv); p.Wgate = (bf16_t*)(ws + O_Wgate);
  p.Lora1 = (bf16_t*)(ws + O_Lora1); p.W2T = (bf16_t*)(ws + O_W2T); p.A2T = (bf16_t*)(ws + O_A2T); p.G2T = (bf16_t*)(ws + O_G2T);
  p.V2T = (bf16_t*)(ws + O_V2T); p.GluT = (bf16_t*)(ws + O_GluT); p.BranchT = (bf16_t*)(ws + O_BranchT); p.WoutT = (bf16_t*)(ws + O_WoutT);
  p.FfnGU = (bf16_t*)(ws + O_FfnGU); p.FfnDown = (bf16_t*)(ws + O_FfnDown);
  p.ropeC = (float*)(ws + O_ropeC); p.ropeS = (float*)(ws + O_ropeS); p.s5A = (float*)(ws + O_s5A); p.s5AL = (float*)(ws + O_s5AL);
  p.s5BB = (float*)(ws + O_s5BB); p.s5st = (float*)(ws + O_s5st); p.lrust = (float*)(ws + O_lrust); p.lse = (float*)(ws + O_lse);
  p.vbuf = (bf16_t*)(ws + O_vbuf); p.h = (bf16_t*)(ws + O_h); p.ya = (bf16_t*)(ws + O_ya); p.yb = (bf16_t*)(ws + O_yb);
  p.yc = (bf16_t*)(ws + O_yc); p.yd = (bf16_t*)(ws + O_yd);
  p.TR = ws + O_TR; p.X = k.X;
  return p;
}

DI int tidx() { int t = __builtin_amdgcn_workitem_id_x(); asm volatile("" : "+v"(t)); return t & 255; }
DI bf16_t f2bf(float x) { unsigned u = __float_as_uint(x); u += 0x7fffu + ((u >> 16) & 1u); return (bf16_t)(u >> 16); }
DI float bf2f(bf16_t b) { return __uint_as_float(((unsigned)b) << 16); }
DI float rl(float x, int l) { return __int_as_float(__builtin_amdgcn_readlane(__float_as_int(x), l)); }
DI float sigmoidf_(float x) { return __builtin_amdgcn_rcpf(1.f + __expf(-x)); }
DI float softplusf_(float z) { return fmaxf(z, 0.f) + __logf(1.f + __expf(-fabsf(z))); }
DI float tanhf_(float x) { return 1.f - 2.f * __builtin_amdgcn_rcpf(1.f + __expf(2.f * x)); }
DI float wave_sum(float x) {
  x += __shfl_xor(x, 32); x += __shfl_xor(x, 16); x += __shfl_xor(x, 8);
  x += __shfl_xor(x, 4); x += __shfl_xor(x, 2); x += __shfl_xor(x, 1);
  return x;
}
DI int first_item(int base, int idx, int stride) { int r = base % stride; int f = idx - r; if (f < 0) f += stride; return f; }

constexpr int LP = 72;

typedef __attribute__((ext_vector_type(4))) unsigned u32x4;
template <int NT, int AMODE, int PF = 2>
DI void gemm_acc(f32x16 (&acc)[2][NT], const bf16_t* __restrict__ A, int lda, int row0,
                 const bf16_t* __restrict__ Bt, int ldb, int brow0, int K, bf16_t* sm) {
  const int tid = tidx();
  const int lane = tid & 63, wave = tid >> 6;
  const int r = lane & 31, hh = lane >> 5;
  const int wm = wave >> 1, wn = wave & 1;
  bf16_t* sA = sm;
  bf16_t* sB = sm + 2 * 128 * LP;
  const int KT = K / 64;
  u32x4 ra0[4], rb0[2 * NT], ra1[4], rb1[2 * NT];

#define GLOAD(KT_, RA, RB)                                                                      \
  {                                                                                             \
    _Pragma("unroll") for (int i = 0; i < 4; i++) {                                             \
      int id = tid + 256 * i; int row = id >> 3, kc = id & 7;                                   \
      int k = (KT_) * 64 + kc * 8;                                                              \
      if (AMODE == 0) {                                                                         \
        RA[i] = *(const u32x4*)(A + (size_t)(row0 + row) * lda + k);                            \
      } else {                                                                                  \
        int grow = row0 + row;                                                                  \
        if (k < 1024) RA[i] = *(const u32x4*)(A + (size_t)grow * 1024 + k);                     \
        else if ((grow & (SEQ - 1)) == 0) RA[i] = (u32x4){0u, 0u, 0u, 0u};                       \
        else RA[i] = *(const u32x4*)(A + (size_t)(grow - 1) * 1024 + (k - 1024));               \
      }                                                                                         \
    }                                                                                           \
    _Pragma("unroll") for (int i = 0; i < 2 * NT; i++) {                                        \
      int id = tid + 256 * i; int row = id >> 3, kc = id & 7;                                   \
      RB[i] = *(const u32x4*)(Bt + (size_t)(brow0 + row) * ldb + (KT_) * 64 + kc * 8);          \
    }                                                                                           \
  }
#define SSTORE(ST_, RA, RB)                                                                     \
  {                                                                                             \
    _Pragma("unroll") for (int i = 0; i < 4; i++) {                                             \
      int id = tid + 256 * i; int row = id >> 3, kc = id & 7;                                   \
      *(u32x4*)(sA + (ST_) * 128 * LP + row * LP + kc * 8) = RA[i];                             \
    }                                                                                           \
    _Pragma("unroll") for (int i = 0; i < 2 * NT; i++) {                                        \
      int id = tid + 256 * i; int row = id >> 3, kc = id & 7;                                   \
      *(u32x4*)(sB + (ST_) * 128 * LP + row * LP + kc * 8) = RB[i];                             \
    }                                                                                           \
  }
  auto compute = [&](int st) __attribute__((always_inline)) {
    const bf16_t* a_base = sA + st * 128 * LP + (wm * 64 + r) * LP + hh * 8;
    const bf16_t* b_base = sB + st * 128 * LP + (wn * 32 * NT + r) * LP + hh * 8;
#pragma unroll
    for (int ks = 0; ks < 4; ks++) {
      bf16x8 af[2], bfr[NT];
#pragma unroll
      for (int mi = 0; mi < 2; mi++) af[mi] = *(const bf16x8*)(a_base + mi * 32 * LP + ks * 16);
#pragma unroll
      for (int ni = 0; ni < NT; ni++) bfr[ni] = *(const bf16x8*)(b_base + ni * 32 * LP + ks * 16);
#pragma unroll
      for (int mi = 0; mi < 2; mi++)
#pragma unroll
        for (int ni = 0; ni < NT; ni++)
          acc[mi][ni] = __builtin_amdgcn_mfma_f32_32x32x16_bf16(af[mi], bfr[ni], acc[mi][ni], 0, 0, 0);
    }
  };

  if (PF == 1) {
    GLOAD(0, ra0, rb0)
    SSTORE(0, ra0, rb0)
    __syncthreads();
#pragma unroll 1
    for (int kt = 0; kt < KT; kt++) {
      const int st = kt & 1;
      if (kt + 1 < KT) GLOAD(kt + 1, ra0, rb0)
      compute(st);
      if (kt + 1 < KT) SSTORE(st ^ 1, ra0, rb0)
      __syncthreads();
    }
    return;
  }
  GLOAD(0, ra0, rb0)
  if (KT > 1) GLOAD(1, ra1, rb1)
  SSTORE(0, ra0, rb0)
  __syncthreads();
#pragma unroll 1
  for (int kt = 0; kt < KT; kt += 2) {
    if (kt + 2 < KT) GLOAD(kt + 2, ra0, rb0)
    compute(0);
    if (kt + 1 < KT) SSTORE(1, ra1, rb1)
    __syncthreads();
    if (kt + 1 >= KT) break;
    if (kt + 3 < KT) GLOAD(kt + 3, ra1, rb1)
    compute(1);
    if (kt + 2 < KT) SSTORE(0, ra0, rb0)
    __syncthreads();
  }
#undef GLOAD
#undef SSTORE
}

template <int NT>
DI void zero_acc(f32x16 (&acc)[2][NT]) {
#pragma unroll
  for (int mi = 0; mi < 2; mi++)
#pragma unroll
    for (int ni = 0; ni < NT; ni++)
#pragma unroll
      for (int i = 0; i < 16; i++) acc[mi][ni][i] = 0.f;
}


#define XT_LOOP(NTN, BASE) \
  for (int pos_ = first_item((BASE), (int)(blockIdx.x >> 3), (int)(gridDim.x >> 3)); pos_ < 32 * (NTN); pos_ += (int)(gridDim.x >> 3))
DI void xt_decode(int pos, int ntn, int& mt, int& nt) {
  const int s = pos / (8 * ntn); const int rem = pos - s * 8 * ntn;
  nt = rem >> 3; mt = 32 * (int)(blockIdx.x & 7) + 8 * s + (rem & 7);
}

#define EPI_VARS                                                     \
  const int lane_ = tidx() & 63, wave_ = tidx() >> 6;      \
  const int er = lane_ & 31, eh = lane_ >> 5, ewm = wave_ >> 1, ewn = wave_ & 1;
#define EPI_ROW(mi, i) (row0 + ewm * 64 + (mi) * 32 + ((i) & 3) + 8 * ((i) >> 2) + 4 * eh)


constexpr int LP4 = 40;
DI void gemm_acc4(f32x16 (&acc)[4][2], const bf16_t* __restrict__ A, int lda, int row0,
                  const bf16_t* __restrict__ Bt, int ldb, int brow0, int K, bf16_t* sm) {
  const int tid = tidx();
  const int lane = tid & 63, wave = tid >> 6;
  const int r = lane & 31, hh = lane >> 5;
  const int wm = wave >> 1, wn = wave & 1;
  bf16_t* sA = sm;
  bf16_t* sB = sm + 2 * 256 * LP4;
  const int KT = K / 32;
  u32x4 ra0[4], rb0[2], ra1[4], rb1[2];
#define GLOAD4(KT_, RA, RB)                                                                     \
  {                                                                                             \
    _Pragma("unroll") for (int i = 0; i < 4; i++) {                                             \
      int id = tid + 256 * i; int row = id >> 2, kc = id & 3;                                   \
      RA[i] = *(const u32x4*)(A + (size_t)(row0 + row) * lda + (KT_) * 32 + kc * 8);            \
    }                                                                                           \
    _Pragma("unroll") for (int i = 0; i < 2; i++) {                                             \
      int id = tid + 256 * i; int row = id >> 2, kc = id & 3;                                   \
      RB[i] = *(const u32x4*)(Bt + (size_t)(brow0 + row) * ldb + (KT_) * 32 + kc * 8);          \
    }                                                                                           \
  }
#define SSTORE4(ST_, RA, RB)                                                                    \
  {                                                                                             \
    _Pragma("unroll") for (int i = 0; i < 4; i++) {                                             \
      int id = tid + 256 * i; int row = id >> 2, kc = id & 3;                                   \
      *(u32x4*)(sA + (ST_) * 256 * LP4 + row * LP4 + kc * 8) = RA[i];                           \
    }                                                                                           \
    _Pragma("unroll") for (int i = 0; i < 2; i++) {                                             \
      int id = tid + 256 * i; int row = id >> 2, kc = id & 3;                                   \
      *(u32x4*)(sB + (ST_) * 128 * LP4 + row * LP4 + kc * 8) = RB[i];                           \
    }                                                                                           \
  }
  auto compute = [&](int st) __attribute__((always_inline)) {
    const bf16_t* a_base = sA + st * 256 * LP4 + (wm * 128 + r) * LP4 + hh * 8;
    const bf16_t* b_base = sB + st * 128 * LP4 + (wn * 64 + r) * LP4 + hh * 8;
#pragma unroll
    for (int ks = 0; ks < 2; ks++) {
      bf16x8 af[4], bfr[2];
#pragma unroll
      for (int mi = 0; mi < 4; mi++) af[mi] = *(const bf16x8*)(a_base + mi * 32 * LP4 + ks * 16);
#pragma unroll
      for (int ni = 0; ni < 2; ni++) bfr[ni] = *(const bf16x8*)(b_base + ni * 32 * LP4 + ks * 16);
#pragma unroll
      for (int mi = 0; mi < 4; mi++)
#pragma unroll
        for (int ni = 0; ni < 2; ni++)
          acc[mi][ni] = __builtin_amdgcn_mfma_f32_32x32x16_bf16(af[mi], bfr[ni], acc[mi][ni], 0, 0, 0);
    }
  };
  GLOAD4(0, ra0, rb0)
  if (KT > 1) GLOAD4(1, ra1, rb1)
  SSTORE4(0, ra0, rb0)
  __syncthreads();
#pragma unroll 1
  for (int kt = 0; kt < KT; kt += 2) {
    if (kt + 2 < KT) GLOAD4(kt + 2, ra0, rb0)
    compute(0);
    if (kt + 1 < KT) SSTORE4(1, ra1, rb1)
    __syncthreads();
    if (kt + 1 >= KT) break;
    if (kt + 3 < KT) GLOAD4(kt + 3, ra1, rb1)
    compute(1);
    if (kt + 2 < KT) SSTORE4(0, ra0, rb0)
    __syncthreads();
  }
#undef GLOAD4
#undef SSTORE4
}
DI void zero_acc4(f32x16 (&acc)[4][2]) {
#pragma unroll
  for (int mi = 0; mi < 4; mi++)
#pragma unroll
    for (int ni = 0; ni < 2; ni++)
#pragma unroll
      for (int i = 0; i < 16; i++) acc[mi][ni][i] = 0.f;
}
#define XT4_LOOP(NTN, BASE) \
  for (int pos_ = first_item((BASE), (int)(blockIdx.x >> 3), (int)(gridDim.x >> 3)); pos_ < 16 * (NTN); pos_ += (int)(gridDim.x >> 3))
DI void xt4_decode(int pos, int ntn, int& mt, int& nt) {
  const int s = pos / (8 * ntn); const int rem = pos - s * 8 * ntn;
  nt = rem >> 3; mt = 16 * (int)(blockIdx.x & 7) + 8 * s + (rem & 7);
}
#define EPI_ROW4(mi, i) (row0 + ewm * 128 + (mi) * 32 + ((i) & 3) + 8 * ((i) >> 2) + 4 * eh)

template <class F>
DI void transpose_job(bf16_t* dst, int N, int K, F f, float* tile, int& base) {
  const int tid = tidx();
  const int ntn = N / 64, ntiles = ntn * (K / 64);
  for (int t = first_item(base, blockIdx.x, gridDim.x); t < ntiles; t += gridDim.x) {
    const int n0 = (t % ntn) * 64, k0 = (t / ntn) * 64;
#pragma unroll 4
    for (int i = 0; i < 16; i++) {
      int k = (tid >> 6) + 4 * i, n = tid & 63;
      tile[k * 65 + n] = f(n0 + n, k0 + k);
    }
    __syncthreads();
#pragma unroll 4
    for (int i = 0; i < 16; i++) {
      int n = (tid >> 6) + 4 * i, k = tid & 63;
      dst[(size_t)(n0 + n) * K + k0 + k] = f2bf(tile[k * 65 + n]);
    }
    __syncthreads();
  }
  base += ntiles;
}

DI int interleave_col(int n) {
  return (n >> 7) * 64 + ((n >> 6) & 1) * 32 + (n & 31);
}

DI void phase_prep(const Params& p, int l, float* smf, int part) {
  int base = 0;
  if (part == 2) {
    const float* fg = p.in[I_W_FFN_GATE] + (size_t)l * 1024 * DFF;
    const float* fu = p.in[I_W_FFN_UP] + (size_t)l * 1024 * DFF;
    const float* fd = p.in[I_W_FFN_DOWN] + (size_t)l * DFF * 1024;
    transpose_job(p.FfnGU, 2 * DFF, 1024, [&](int n, int k) {
      int j = interleave_col(n);
      return ((n >> 5) & 1) ? fu[(size_t)k * DFF + j] : fg[(size_t)k * DFF + j];
    }, smf, base);
    transpose_job(p.FfnDown, 1024, DFF, [&](int n, int k) { return fd[(size_t)k * 1024 + n]; }, smf, base);
    return;
  }
  const float* w_in = p.in[I_W_IN] + (size_t)l * DM * NIN;
  transpose_job(p.Wqkv, 1536, 1024, [&](int n, int k) { return w_in[(size_t)k * NIN + n]; }, smf, base);
  transpose_job(p.Wux, 1024, 1024, [&](int n, int k) { return w_in[(size_t)k * NIN + (n < 512 ? 1536 + n : 3584 + n - 512)]; }, smf, base);
  transpose_job(p.Wrkv, 1536, 1024, [&](int n, int k) { return w_in[(size_t)k * NIN + 2048 + n]; }, smf, base);
  transpose_job(p.Wgate, 4096, 1024, [&](int n, int k) { return w_in[(size_t)k * NIN + 4096 + n]; }, smf, base);
  {
    const float* w1 = p.in[I_RW_W1] + (size_t)l * 1024 * 64;
    const float* a1 = p.in[I_RW_A1] + (size_t)l * 1024 * 64;
    const float* g1 = p.in[I_RW_G1] + (size_t)l * 1024 * 128;
    const float* v1 = p.in[I_RW_V1] + (size_t)(l > 0 ? l - 1 : 0) * 1024 * 32;
    const float* muw = p.in[I_RW_MU_WAG] + (size_t)l * 3 * 1024;
    const float* muv = p.in[I_RW_MU_V] + (size_t)(l > 0 ? l - 1 : 0) * 1024;
    transpose_job(p.Lora1, 320, 2048, [&](int n, int k) {
      int kk = k & 1023; bool hi = k >= 1024;
      float w, mu;
      if (n < 64) { w = w1[kk * 64 + n]; mu = muw[kk]; }
      else if (n < 128) { w = a1[kk * 64 + n - 64]; mu = muw[1024 + kk]; }
      else if (n < 256) { w = g1[kk * 128 + n - 128]; mu = muw[2048 + kk]; }
      else if (n < 288 && l > 0) { w = v1[kk * 32 + n - 256]; mu = muv[kk]; }
      else { w = 0.f; mu = 0.f; }
      return hi ? mu * w : (1.f - mu) * w;
    }, smf, base);
    const float* w2 = p.in[I_RW_W2] + (size_t)l * 64 * 512;
    const float* a2 = p.in[I_RW_A2] + (size_t)l * 64 * 512;
    const float* g2 = p.in[I_RW_G2] + (size_t)l * 128 * 512;
    const float* v2 = p.in[I_RW_V2] + (size_t)(l > 0 ? l - 1 : 0) * 32 * 512;
    transpose_job(p.W2T, 512, 64, [&](int n, int k) { return w2[k * 512 + n]; }, smf, base);
    transpose_job(p.A2T, 512, 64, [&](int n, int k) { return a2[k * 512 + n]; }, smf, base);
    transpose_job(p.G2T, 512, 128, [&](int n, int k) { return g2[k * 512 + n]; }, smf, base);
    transpose_job(p.V2T, 512, 64, [&](int n, int k) { return (k < 32 && l > 0) ? v2[k * 512 + n] : 0.f; }, smf, base);
  }
  {
    const float* wg = p.in[I_S5_W_GLU] + (size_t)l * 512 * 1024;
    transpose_job(p.GluT, 1024, 512, [&](int n, int k) {
      int j = interleave_col(n); int col = ((n >> 5) & 1) ? 512 + j : j;
      return wg[(size_t)k * 1024 + col];
    }, smf, base);
  }
  for (int nb = 0; nb < 4; nb++) {
    const float* wb = p.in[I_W_BRANCH] + ((size_t)l * 4 + nb) * 512 * 1024;
    transpose_job(p.BranchT + (size_t)nb * 1024 * 512, 1024, 512, [&](int n, int k) { return wb[(size_t)k * 1024 + n]; }, smf, base);
  }
  {
    const float* wo = p.in[I_W_OUT] + (size_t)l * 1024 * 1024;
    transpose_job(p.WoutT, 1024, 1024, [&](int n, int k) { return wo[(size_t)k * 1024 + n]; }, smf, base);
  }
  {
    const int gt = blockIdx.x * 256 + tidx(), gs = gridDim.x * 256;
    for (int it = gt; it < 2048; it += gs) {
      int g = it >> 6;
      float lr = p.in[I_S5_LAM_RE][l * 2048 + it], li = p.in[I_S5_LAM_IM][l * 2048 + it];
      float dt = expf(p.in[I_S5_LOG_DT][l * 32 + g]);
      float mag = expf(lr * dt);
      float sn, cs; sincosf(li * dt, &sn, &cs);
      float abr = mag * cs, abi = mag * sn;
      float nr = abr - 1.f, den = lr * lr + li * li;
      float fr = (nr * lr + abi * li) / den, fi = (abi * lr - nr * li) / den;
      p.s5A[it * 2] = abr; p.s5A[it * 2 + 1] = abi;
      float pr = abr, pi = abi;
      for (int s = 0; s < 7; s++) { float t = pr * pr - pi * pi; pi = 2.f * pr * pi; pr = t; }
      p.s5AL[it * 2] = pr; p.s5AL[it * 2 + 1] = pi;
      const float* br = p.in[I_S5_B_RE] + ((size_t)l * 2048 + it) * 16;
      const float* bi = p.in[I_S5_B_IM] + ((size_t)l * 2048 + it) * 16;
      for (int c = 0; c < 16; c++) {
        p.s5BB[it * 32 + c] = fr * br[c] - fi * bi[c];
        p.s5BB[it * 32 + 16 + c] = fr * bi[c] + fi * br[c];
      }
    }
    if (l == 0) {
      for (int it = gt; it < SEQ * 32; it += gs) {
        int pos = it >> 5, i = it & 31;
        float inv = (float)exp(-((double)i / 32.0) * 9.210340371976184);
        float ang = (float)pos * inv;
        double a = (double)ang;
        a -= 6.283185307179586 * rint(a * 0.15915494309189535);
        float sn, cs; sincosf((float)a, &sn, &cs);
        p.ropeC[it] = cs; p.ropeS[it] = sn;
      }
    }
  }
}

DI void rmsnorm_rows(const float* X, const float* gamma, bf16_t* outb, float* outf) {
  const int lane = tidx() & 63, wave = tidx() >> 6;
  for (int row = blockIdx.x * 4 + wave; row < TOK; row += gridDim.x * 4) {
    const float4* xr = (const float4*)(X + (size_t)row * DM);
    float4 v[4]; float ss = 0.f;
#pragma unroll
    for (int i = 0; i < 4; i++) { v[i] = xr[lane + 64 * i]; ss += v[i].x * v[i].x + v[i].y * v[i].y + v[i].z * v[i].z + v[i].w * v[i].w; }
    ss = wave_sum(ss);
    float rs = rsqrtf(ss * (1.f / DM) + 1e-6f);
#pragma unroll
    for (int i = 0; i < 4; i++) {
      float4 g = ((const float4*)gamma)[lane + 64 * i];
      float o0 = v[i].x * rs * g.x, o1 = v[i].y * rs * g.y, o2 = v[i].z * rs * g.z, o3 = v[i].w * rs * g.w;
      if (outb) {
        uint2 pk; pk.x = (unsigned)f2bf(o0) | ((unsigned)f2bf(o1) << 16); pk.y = (unsigned)f2bf(o2) | ((unsigned)f2bf(o3) << 16);
        *(uint2*)(outb + (size_t)row * DM + (lane + 64 * i) * 4) = pk;
      } else {
        ((float4*)(outf + (size_t)row * DM))[lane + 64 * i] = make_float4(o0, o1, o2, o3);
      }
    }
  }
}

DI void phase_gemm_qkv(const Params& p, bf16_t* sm) {
  bf16_t* qkv = (bf16_t*)p.TR;
  EPI_VARS
  XT4_LOOP(12, 0) {
    int mt_, nt_; xt4_decode(pos_, 12, mt_, nt_);
    const int row0 = mt_ * 256, n0 = nt_ * 128;
    f32x16 acc[4][2]; zero_acc4(acc);
    gemm_acc4(acc, p.h, 1024, row0, p.Wqkv, 1024, n0, 1024, sm);
#pragma unroll
    for (int mi = 0; mi < 4; mi++)
#pragma unroll
      for (int i = 0; i < 16; i++) {
        const int row = EPI_ROW4(mi, i);
        const int col = n0 + ewn * 64 + er;
        float x1 = acc[mi][0][i], x2 = acc[mi][1][i];
        if (n0 < 1024) {
          int pos = row & (SEQ - 1);
          float c = p.ropeC[pos * 32 + er], s = p.ropeS[pos * 32 + er];
          float o1 = x1 * c - x2 * s, o2 = x2 * c + x1 * s;
          if (n0 < 512) { o1 *= 0.125f; o2 *= 0.125f; }
          x1 = o1; x2 = o2;
        }
        qkv[(size_t)row * 1536 + col] = f2bf(x1);
        qkv[(size_t)row * 1536 + col + 32] = f2bf(x2);
      }
  }
}

DI void phase_gemm_plain(const bf16_t* A, int K, const bf16_t* Bt, int ntn, bf16_t* d0, bf16_t* d1, int nsplit, int ldd, bf16_t* sm, int& base) {
  EPI_VARS
  const int ntiles = 16 * ntn;
  XT4_LOOP(ntn, base) {
    int mt_, nt_; xt4_decode(pos_, ntn, mt_, nt_);
    const int row0 = mt_ * 256, n0 = nt_ * 128;
    f32x16 acc[4][2]; zero_acc4(acc);
    gemm_acc4(acc, A, K, row0, Bt, K, n0, K, sm);
    bf16_t* d = (n0 < nsplit) ? d0 : d1;
    const int cb = (n0 < nsplit) ? n0 : n0 - nsplit;
#pragma unroll
    for (int mi = 0; mi < 4; mi++)
#pragma unroll
      for (int ni = 0; ni < 2; ni++)
#pragma unroll
        for (int i = 0; i < 16; i++) {
          const int row = EPI_ROW4(mi, i);
          d[(size_t)row * ldd + cb + ewn * 64 + ni * 32 + er] = f2bf(acc[mi][ni][i]);
        }
  }
  base += ntiles;
}

DI void phase_lora1(const Params& p, bf16_t* lo1, bf16_t* sm, int& base) {
  EPI_VARS
  const int ntiles = 32 * 5;
  XT_LOOP(5, base) {
    int mt_, nt_; xt_decode(pos_, 5, mt_, nt_);
    const int row0 = mt_ * 128, n0 = nt_ * 64;
    f32x16 acc[2][1]; zero_acc<1>(acc);
    gemm_acc<1, 1>(acc, p.h, 1024, row0, p.Lora1, 2048, n0, 2048, sm);
#pragma unroll
    for (int mi = 0; mi < 2; mi++)
#pragma unroll
      for (int i = 0; i < 16; i++) {
        const int row = EPI_ROW(mi, i);
        const int col = n0 + ewn * 32 + er;
        float x = acc[mi][0][i];
        if (col < 64) x = tanhf_(x);
        else if (col >= 128 && col < 256) x = sigmoidf_(x);
        lo1[(size_t)row * 320 + col] = f2bf(x);
      }
  }
  base += ntiles;
}

template <int KIND>
DI void lora2_tile(const Params& p, int l, const bf16_t* lo1, bf16_t* lo2, const bf16_t* rkv, bf16_t* sm, int row0, int n0) {
  EPI_VARS
  const float* w0 = p.in[I_RW_W0] + l * 512;
  const float* a0 = p.in[I_RW_A0] + l * 512;
  const float* v0 = p.in[I_RW_V0] + (l > 0 ? l - 1 : 0) * 512;
  const float* muv = p.in[I_RW_MU_RKV] + (size_t)l * 3 * 512 + 1024;
  f32x16 acc[2][2]; zero_acc<2>(acc);
  const bf16_t* Bt = (KIND == 0) ? p.W2T : (KIND == 1) ? p.A2T : (KIND == 2) ? p.G2T : p.V2T;
  const int K = (KIND == 2) ? 128 : 64;
  const int aoff = (KIND == 0) ? 0 : (KIND == 1) ? 64 : (KIND == 2) ? 128 : 256;
  gemm_acc<2, 0>(acc, lo1 + aoff, 320, row0, Bt, K, n0, K, sm);
#pragma unroll
  for (int mi = 0; mi < 2; mi++)
#pragma unroll
    for (int ni = 0; ni < 2; ni++) {
#pragma unroll
      for (int i = 0; i < 16; i++) {
        const int row = EPI_ROW(mi, i);
        const int col = n0 + ewn * 64 + ni * 32 + er;
        const unsigned o = (unsigned)row * 512u + (unsigned)col;
        float x = acc[mi][ni][i];
        if (KIND == 0) {
          float wl = -softplusf_(-(w0[col] + x)) - 0.5f;
          lo2[o] = f2bf(__expf(wl));
        } else if (KIND == 1) {
          lo2[(size_t)TOK * 512 + o] = f2bf(sigmoidf_(a0[col] + x));
        } else if (KIND == 2) {
          lo2[(size_t)2 * TOK * 512 + o] = f2bf(x);
        } else {
          float vg = sigmoidf_(v0[col] + x);
          const unsigned ro = (unsigned)row * 1536u + 1024u + (unsigned)col;
          float vc = bf2f(rkv[ro]);
          float vp = (row & (SEQ - 1)) ? bf2f(rkv[ro - 1536u]) : 0.f;
          float vl = vc + (vp - vc) * muv[col];
          float vf = bf2f(p.vbuf[o]);
          p.vbuf[o] = f2bf(vl + (vf - vl) * vg);
        }
      }
      asm volatile("" ::: "memory");
    }
}

DI void phase_lora2(const Params& p, int l, const bf16_t* lo1, bf16_t* lo2, const bf16_t* rkv, bf16_t* sm, int& base) {
  const int nk = (l > 0) ? 4 : 3;
  const int ntiles = 32 * 4 * nk;
  XT_LOOP(4 * nk, base) {
    int mt_, nt_; xt_decode(pos_, 4 * nk, mt_, nt_);
    const int kind = nt_ % nk;
    const int row0 = mt_ * 128, n0 = (nt_ / nk) * 128;
    if (kind == 0) lora2_tile<0>(p, l, lo1, lo2, rkv, sm, row0, n0);
    else if (kind == 1) lora2_tile<1>(p, l, lo1, lo2, rkv, sm, row0, n0);
    else if (kind == 2) lora2_tile<2>(p, l, lo1, lo2, rkv, sm, row0, n0);
    else lora2_tile<3>(p, l, lo1, lo2, rkv, sm, row0, n0);
  }
  base += ntiles;
}

DI void phase_vlerp(const Params& p, int l, const bf16_t* rkv) {
  const float* muv = p.in[I_RW_MU_RKV] + (size_t)l * 3 * 512 + 1024;
  const size_t n = (size_t)TOK * 512;
  for (size_t e = (size_t)blockIdx.x * 256 + tidx(); e < n; e += (size_t)gridDim.x * 256) {
    int row = (int)(e >> 9), col = (int)(e & 511);
    float vc = bf2f(rkv[(size_t)row * 1536 + 1024 + col]);
    float vp = (row & (SEQ - 1)) ? bf2f(rkv[(size_t)(row - 1) * 1536 + 1024 + col]) : 0.f;
    p.vbuf[e] = f2bf(vc + (vp - vc) * muv[col]);
  }
}

DI void phase_glu(const Params& p, int l, const bf16_t* ybpre, bf16_t* sm, int& base) {
  EPI_VARS
  const float* bg = p.in[I_S5_B_GLU] + l * 1024;
  const int ntiles = 16 * 8;
  XT4_LOOP(8, base) {
    int mt_, tn; xt4_decode(pos_, 8, mt_, tn);
    const int row0 = mt_ * 256;
    f32x16 acc[4][2]; zero_acc4(acc);
    gemm_acc4(acc, ybpre, 512, row0, p.GluT, 512, tn * 128, 512, sm);
#pragma unroll
    for (int mi = 0; mi < 4; mi++)
#pragma unroll
      for (int i = 0; i < 16; i++) {
        const int row = EPI_ROW4(mi, i);
        const int j = tn * 64 + ewn * 32 + er;
        float val = acc[mi][0][i] + bg[j], gate = acc[mi][1][i] + bg[512 + j];
        p.yb[(size_t)row * 512 + j] = f2bf(val * sigmoidf_(gate));
      }
  }
  base += ntiles;
}

DI void phase_merge(const Params& p, bf16_t* merged, bf16_t* sm) {
  EPI_VARS
  XT_LOOP(8, 0) {
    int mt_, nt_; xt_decode(pos_, 8, mt_, nt_);
    const int row0 = mt_ * 128, n0 = nt_ * 128;
    unsigned mgp[2][2][8];
#pragma unroll
    for (int mi = 0; mi < 2; mi++)
#pragma unroll
      for (int ni = 0; ni < 2; ni++)
#pragma unroll
        for (int q = 0; q < 8; q++) mgp[mi][ni][q] = 0u;
#pragma unroll 1
    for (int nb = 0; nb < 4; nb++) {
      const bf16_t* y = (nb == 0) ? p.ya : (nb == 1) ? p.yb : (nb == 2) ? p.yc : p.yd;
      unsigned zp[2][2][8];
      {
        f32x16 az[2][2]; zero_acc<2>(az);
        gemm_acc<2, 0, 1>(az, y, 512, row0, p.BranchT + (size_t)nb * 1024 * 512, 512, n0, 512, sm);
#pragma unroll
        for (int mi = 0; mi < 2; mi++)
#pragma unroll
          for (int ni = 0; ni < 2; ni++)
#pragma unroll
            for (int q = 0; q < 8; q++)
              zp[mi][ni][q] = (unsigned)f2bf(az[mi][ni][2 * q]) | ((unsigned)f2bf(az[mi][ni][2 * q + 1]) << 16);
      }
      f32x16 ag[2][2]; zero_acc<2>(ag);
      gemm_acc<2, 0, 1>(ag, p.h, 1024, row0, p.Wgate + (size_t)nb * 1024 * 1024, 1024, n0, 1024, sm);
#pragma unroll
      for (int mi = 0; mi < 2; mi++)
#pragma unroll
        for (int ni = 0; ni < 2; ni++)
#pragma unroll
          for (int q = 0; q < 8; q++) {
            const unsigned z = zp[mi][ni][q], m = mgp[mi][ni][q];
            const float m0 = __uint_as_float(m << 16) + sigmoidf_(ag[mi][ni][2 * q]) * __uint_as_float(z << 16);
            const float m1 = __uint_as_float(m & 0xffff0000u) + sigmoidf_(ag[mi][ni][2 * q + 1]) * __uint_as_float(z & 0xffff0000u);
            mgp[mi][ni][q] = (unsigned)f2bf(m0) | ((unsigned)f2bf(m1) << 16);
          }
    }
#pragma unroll
    for (int mi = 0; mi < 2; mi++)
#pragma unroll
      for (int ni = 0; ni < 2; ni++)
#pragma unroll
        for (int q = 0; q < 8; q++) {
          const int r0 = EPI_ROW(mi, 2 * q), r1 = EPI_ROW(mi, 2 * q + 1);
          const int col = n0 + ewn * 64 + ni * 32 + er;
          merged[(size_t)r0 * 1024 + col] = (bf16_t)(mgp[mi][ni][q] & 0xffffu);
          merged[(size_t)r1 * 1024 + col] = (bf16_t)(mgp[mi][ni][q] >> 16);
        }
  }
}

DI void phase_gemm_resid(const bf16_t* A, int K, const bf16_t* Bt, const float* Xin, float* Xout, bf16_t* sm) {
  EPI_VARS
  XT_LOOP(8, 0) {
    int mt_, nt_; xt_decode(pos_, 8, mt_, nt_);
    const int row0 = mt_ * 128, n0 = nt_ * 128;
    f32x16 acc[2][2]; zero_acc<2>(acc);
    gemm_acc<2, 0>(acc, A, K, row0, Bt, K, n0, K, sm);
    float xin[2][16];
#define RESID_LOAD(G)                                                                                         \
    {                                                                                                         \
      unsigned ob = (unsigned)(row0 + ewm * 64 + ((G) >> 1) * 32 + 4 * eh) * 1024u +                          \
                    (unsigned)(n0 + ewn * 64 + ((G) & 1) * 32 + er);                                          \
      asm volatile("" : "+v"(ob));                                                                            \
      _Pragma("unroll") for (int i = 0; i < 16; i++)                                                          \
        xin[(G) & 1][i] = Xin[ob + (unsigned)(((i & 3) + 8 * (i >> 2)) * 1024)];                              \
    }
    RESID_LOAD(0)
#pragma unroll
    for (int g = 0; g < 4; g++) {
      if (g + 1 < 4) RESID_LOAD(g + 1)
      asm volatile("" ::: "memory");
      unsigned ob = (unsigned)(row0 + ewm * 64 + (g >> 1) * 32 + 4 * eh) * 1024u + (unsigned)(n0 + ewn * 64 + (g & 1) * 32 + er);
      asm volatile("" : "+v"(ob));
#pragma unroll
      for (int i = 0; i < 16; i++)
        Xout[ob + (unsigned)(((i & 3) + 8 * (i >> 2)) * 1024)] = xin[g & 1][i] + acc[g >> 1][g & 1][i];
      asm volatile("" ::: "memory");
    }
#undef RESID_LOAD
  }
}

DI void phase_ffn_up(const Params& p, bf16_t* ffh, bf16_t* sm) {
  EPI_VARS
  XT4_LOOP(44, 0) {
    int mt_, tn; xt4_decode(pos_, 44, mt_, tn);
    const int row0 = mt_ * 256;
    f32x16 acc[4][2]; zero_acc4(acc);
    gemm_acc4(acc, p.h, 1024, row0, p.FfnGU, 1024, tn * 128, 1024, sm);
#pragma unroll
    for (int mi = 0; mi < 4; mi++)
#pragma unroll
      for (int i = 0; i < 16; i++) {
        const int row = EPI_ROW4(mi, i);
        const int j = tn * 64 + ewn * 32 + er;
        float g = acc[mi][0][i], u = acc[mi][1][i];
        ffh[(size_t)row * DFF + j] = f2bf(g * sigmoidf_(g) * u);
      }
  }
}

constexpr int VTP = 260;
DI void phase_attention(const Params& p, bf16_t* sm) {
  const bf16_t* qkv = (const bf16_t*)p.TR;
  bf16_t* og = (bf16_t*)(p.TR + (size_t)TOK * 1536 * 2);
  bf16_t* Ks = sm;
  bf16_t* Vs = sm + 256 * LP;
  const int tid = tidx(), lane = tid & 63, w = tid >> 6;
  const int r = lane & 31, hh = lane >> 5;
  for (int item = blockIdx.x; item < 3 * 2048; item += gridDim.x) {
    const int g = item / 2048, rem = item % 2048;
    const int dsh = 2 * g, d = 1 << dsh;
    const int b = rem >> 10, head = (rem >> 7) & 7, qb = rem & 127;
    const int rho = qb & (d - 1), blk = qb >> dsh;
    {
      const int kj = tid;
      const int sub = blk * 128 - 128 + kj;
      uint4 kv[8], vv[8];
      if (sub >= 0) {
        const size_t tokk = (size_t)b * SEQ + (size_t)sub * d + rho;
        const uint4* kp = (const uint4*)(qkv + tokk * 1536 + 512 + head * 64);
        const uint4* vp = (const uint4*)(qkv + tokk * 1536 + 1024 + head * 64);
#pragma unroll
        for (int c = 0; c < 8; c++) { kv[c] = kp[c]; vv[c] = vp[c]; }
      } else {
#pragma unroll
        for (int c = 0; c < 8; c++) { kv[c] = make_uint4(0, 0, 0, 0); vv[c] = make_uint4(0, 0, 0, 0); }
      }
#pragma unroll
      for (int c = 0; c < 8; c++) {
        *(uint4*)(Ks + kj * LP + c * 8) = kv[c];
        *(uint4*)(Vs + kj * LP + c * 8) = vv[c];
      }
    }
    __syncthreads();
    const int qi = 32 * w + r;
    const size_t tokq = (size_t)b * SEQ + (size_t)(blk * 128 + qi) * d + rho;
    bf16x8 qf[4];
#pragma unroll
    for (int ks = 0; ks < 4; ks++) qf[ks] = *(const bf16x8*)(qkv + tokq * 1536 + head * 64 + ks * 16 + hh * 8);
    f32x16 O[2];
#pragma unroll
    for (int i = 0; i < 16; i++) { O[0][i] = 0.f; O[1][i] = 0.f; }
    float m = -1e30f, lsum = 0.f;
    int kt0 = w; if (blk == 0 && kt0 < 4) kt0 = 4;
    for (int kt = kt0; kt <= w + 4; kt++) {
      f32x16 s;
#pragma unroll
      for (int i = 0; i < 16; i++) s[i] = 0.f;
#pragma unroll
      for (int ks = 0; ks < 4; ks++) {
        bf16x8 kf = *(const bf16x8*)(Ks + (kt * 32 + r) * LP + ks * 16 + hh * 8);
        s = __builtin_amdgcn_mfma_f32_32x32x16_bf16(kf, qf[ks], s, 0, 0, 0);
      }
      float mloc = -1e30f;
      bool valid[16];
#pragma unroll
      for (int i = 0; i < 16; i++) {
        int kj = kt * 32 + (i & 3) + 8 * (i >> 2) + 4 * hh;
        int dist = qi + 128 - kj;
        valid[i] = (dist >= 0) && (dist <= 128) && (blk > 0 || kj >= 128);
        if (valid[i]) mloc = fmaxf(mloc, s[i]);
      }
      mloc = fmaxf(mloc, __shfl_xor(mloc, 32));
      float mnew = fmaxf(m, mloc);
      float alpha = __expf(m - mnew);
      float ps = 0.f;
      float pv[16];
#pragma unroll
      for (int i = 0; i < 16; i++) { pv[i] = valid[i] ? __expf(s[i] - mnew) : 0.f; ps += pv[i]; }
      ps += __shfl_xor(ps, 32);
      lsum = lsum * alpha + ps;
      m = mnew;
#pragma unroll
      for (int i = 0; i < 16; i++) { O[0][i] *= alpha; O[1][i] *= alpha; }
      bf16x8 pf[2];
#pragma unroll
      for (int s2 = 0; s2 < 2; s2++)
#pragma unroll
        for (int j = 0; j < 8; j++) pf[s2][j] = (short)f2bf(pv[8 * s2 + j]);
#pragma unroll
      for (int dt = 0; dt < 2; dt++)
#pragma unroll
        for (int s2 = 0; s2 < 2; s2++) {
          const int i16 = lane & 15, tq = i16 >> 2, tp = i16 & 3, tblk = (lane >> 4) & 1;
          const bf16_t* vb = Vs + (kt * 32 + 16 * s2 + 4 * hh + tq) * LP + dt * 32 + 16 * tblk + 4 * tp;
          s16x4 lo = __builtin_amdgcn_ds_read_tr16_b64_v4i16((__attribute__((address_space(3))) s16x4*)(vb));
          s16x4 hi = __builtin_amdgcn_ds_read_tr16_b64_v4i16((__attribute__((address_space(3))) s16x4*)(vb + 8 * LP));
          bf16x8 vf = __builtin_shufflevector(lo, hi, 0, 1, 2, 3, 4, 5, 6, 7);
          O[dt] = __builtin_amdgcn_mfma_f32_32x32x16_bf16(vf, pf[s2], O[dt], 0, 0, 0);
        }
    }
    const float inv = 1.f / lsum;
    bf16_t* od = og + (size_t)g * TOK * 512 + tokq * 512 + head * 64;
#pragma unroll
    for (int dt = 0; dt < 2; dt++)
#pragma unroll
      for (int gq = 0; gq < 4; gq++) {
        uint2 pk;
        pk.x = (unsigned)f2bf(O[dt][4 * gq] * inv) | ((unsigned)f2bf(O[dt][4 * gq + 1] * inv) << 16);
        pk.y = (unsigned)f2bf(O[dt][4 * gq + 2] * inv) | ((unsigned)f2bf(O[dt][4 * gq + 3] * inv) << 16);
        *(uint2*)(od + dt * 32 + 8 * gq + 4 * hh) = pk;
      }
    if (hh == 0) p.lse[(size_t)g * TOK * 8 + tokq * 8 + head] = m + __logf(lsum);
    __syncthreads();
  }
}

DI void phase_attn_combine(const Params& p) {
  const bf16_t* og = (const bf16_t*)(p.TR + (size_t)TOK * 1536 * 2);
  const size_t n = (size_t)TOK * 64;
  for (size_t e = (size_t)blockIdx.x * 256 + tidx(); e < n; e += (size_t)gridDim.x * 256) {
    const size_t tok = e >> 6; const int cg8 = (int)(e & 63); const int head = cg8 >> 3;
    float l0 = p.lse[tok * 8 + head], l1 = p.lse[(size_t)TOK * 8 + tok * 8 + head], l2 = p.lse[(size_t)2 * TOK * 8 + tok * 8 + head];
    float mx = fmaxf(l0, fmaxf(l1, l2));
    float w0 = __expf(l0 - mx), w1 = __expf(l1 - mx), w2 = __expf(l2 - mx);
    float inv = 1.f / (w0 + w1 + w2);
    w0 *= inv; w1 *= inv; w2 *= inv;
    uint4 a = *(const uint4*)(og + tok * 512 + cg8 * 8);
    uint4 bq = *(const uint4*)(og + (size_t)TOK * 512 + tok * 512 + cg8 * 8);
    uint4 c = *(const uint4*)(og + (size_t)2 * TOK * 512 + tok * 512 + cg8 * 8);
    unsigned aa[4] = {a.x, a.y, a.z, a.w}, bb[4] = {bq.x, bq.y, bq.z, bq.w}, cc[4] = {c.x, c.y, c.z, c.w}, oo[4];
#pragma unroll
    for (int q = 0; q < 4; q++) {
      float lo = w0 * bf2f((bf16_t)(aa[q] & 0xffff)) + w1 * bf2f((bf16_t)(bb[q] & 0xffff)) + w2 * bf2f((bf16_t)(cc[q] & 0xffff));
      float hi = w0 * bf2f((bf16_t)(aa[q] >> 16)) + w1 * bf2f((bf16_t)(bb[q] >> 16)) + w2 * bf2f((bf16_t)(cc[q] >> 16));
      oo[q] = (unsigned)f2bf(lo) | ((unsigned)f2bf(hi) << 16);
    }
    *(uint4*)(p.ya + tok * 512 + cg8 * 8) = make_uint4(oo[0], oo[1], oo[2], oo[3]);
  }
}

DI float gelu_tanh(float x) {
  float u = 0.7978845608028654f * (x + 0.044715f * x * x * x);
  return 0.5f * x * (1.f + tanhf_(u));
}

constexpr int XSP = 136;
template <bool PASS2>
DI void s5_item(const Params& p, int l, int item, int lane, const bf16_t* ubuf, bf16_t* ybpre, bf16_t* xs, float* bus) {
  const int b = item / (32 * NCH5), g = (item / NCH5) % 32, c = item % NCH5;
  const int gp = g * 64 + lane;
  const int r = lane & 31, hh = lane >> 5;
  const float ar = p.s5A[gp * 2], ai = p.s5A[gp * 2 + 1];
  bf16x8 bf_[4];
#pragma unroll
  for (int mt = 0; mt < 4; mt++) {
    const float* src = p.s5BB + (size_t)(g * 64 + 32 * (mt & 1) + r) * 32 + ((mt >> 1) ? 16 : 0) + 8 * hh;
#pragma unroll
    for (int j = 0; j < 8; j++) bf_[mt][j] = (short)f2bf(src[j]);
  }
  bf16x8 cf[8];
  if (PASS2) {
    const float* cr = p.in[I_S5_C_RE] + ((size_t)l * 32 + g) * 16 * 64;
    const float* ci = p.in[I_S5_C_IM] + ((size_t)l * 32 + g) * 16 * 64;
#pragma unroll
    for (int ks = 0; ks < 8; ks++)
#pragma unroll
      for (int j = 0; j < 8; j++) {
        const int k = 16 * ks + 8 * hh + j;
        float v = 0.f;
        if (r < 16) v = (ks < 4) ? cr[r * 64 + k] : -ci[r * 64 + (k - 64)];
        cf[ks][j] = (short)f2bf(v);
      }
  }
  float* st = p.s5st + ((size_t)((b * 32 + g) * NCH5 + c) * 64 + lane) * 2;
  float xr = 0.f, xi = 0.f;
  if (PASS2) { xr = st[0]; xi = st[1]; }
  const size_t tok0 = (size_t)b * SEQ + (size_t)c * LC5;
#pragma unroll 1
  for (int tb = 0; tb < LC5; tb += 32) {
    const bf16x8 uf = *(const bf16x8*)(ubuf + (tok0 + tb + r) * 512 + g * 16 + 8 * hh);
    f32x16 D[4];
#pragma unroll
    for (int mt = 0; mt < 4; mt++) {
#pragma unroll
      for (int i = 0; i < 16; i++) D[mt][i] = 0.f;
      D[mt] = __builtin_amdgcn_mfma_f32_32x32x16_bf16(bf_[mt], uf, D[mt], 0, 0, 0);
    }
#pragma unroll
    for (int half = 0; half < 2; half++) {
      __builtin_amdgcn_fence(__ATOMIC_RELEASE, "wavefront");
      __builtin_amdgcn_wave_barrier();
      if ((r >> 4) == half) {
#pragma unroll
        for (int mt = 0; mt < 4; mt++)
#pragma unroll
          for (int i = 0; i < 16; i++)
            bus[(32 * mt + (i & 3) + 8 * (i >> 2) + 4 * hh) * 17 + (r & 15)] = D[mt][i];
      }
      __builtin_amdgcn_fence(__ATOMIC_RELEASE, "wavefront");
      __builtin_amdgcn_wave_barrier();
      __builtin_amdgcn_fence(__ATOMIC_ACQUIRE, "wavefront");
#pragma unroll 4
      for (int t = 0; t < 16; t++) {
        const float bur = bus[lane * 17 + t], bui = bus[(64 + lane) * 17 + t];
        const float nxr = ar * xr - ai * xi + bur, nxi = ar * xi + ai * xr + bui;
        xr = nxr; xi = nxi;
        if (PASS2) {
          xs[(half * 16 + t) * XSP + lane] = f2bf(xr);
          xs[(half * 16 + t) * XSP + 64 + lane] = f2bf(xi);
        }
      }
    }
    if (PASS2) {
      __builtin_amdgcn_fence(__ATOMIC_RELEASE, "wavefront");
      __builtin_amdgcn_wave_barrier();
      __builtin_amdgcn_fence(__ATOMIC_ACQUIRE, "wavefront");
      f32x16 acc;
#pragma unroll
      for (int i = 0; i < 16; i++) acc[i] = 0.f;
#pragma unroll
      for (int ks = 0; ks < 8; ks++) {
        const bf16x8 xf = *(const bf16x8*)(xs + r * XSP + ks * 16 + hh * 8);
        acc = __builtin_amdgcn_mfma_f32_32x32x16_bf16(cf[ks], xf, acc, 0, 0, 0);
      }
      const size_t tok = tok0 + tb + r;
#pragma unroll
      for (int q = 0; q < 2; q++) {
        const int c0 = 8 * q + 4 * hh;
        const uint2 uu = *(const uint2*)(ubuf + tok * 512 + g * 16 + c0);
        const float4 dd = *(const float4*)(p.in[I_S5_D] + l * 512 + g * 16 + c0);
        const float u0 = bf2f((bf16_t)(uu.x & 0xffff)), u1 = bf2f((bf16_t)(uu.x >> 16));
        const float u2 = bf2f((bf16_t)(uu.y & 0xffff)), u3 = bf2f((bf16_t)(uu.y >> 16));
        const float o0 = gelu_tanh(acc[4 * q + 0] + dd.x * u0), o1 = gelu_tanh(acc[4 * q + 1] + dd.y * u1);
        const float o2 = gelu_tanh(acc[4 * q + 2] + dd.z * u2), o3 = gelu_tanh(acc[4 * q + 3] + dd.w * u3);
        uint2 pk;
        pk.x = (unsigned)f2bf(o0) | ((unsigned)f2bf(o1) << 16);
        pk.y = (unsigned)f2bf(o2) | ((unsigned)f2bf(o3) << 16);
        *(uint2*)(ybpre + tok * 512 + g * 16 + c0) = pk;
      }
    }
  }
  if (!PASS2) { st[0] = xr; st[1] = xi; }
}

DI void s5_carry(const Params& p) {
  const int gt = blockIdx.x * 256 + tidx();
  if (gt < 4096) {
    const int bg = gt >> 6, lane = gt & 63; const int g = bg & 31;
    const float alr = p.s5AL[(g * 64 + lane) * 2], ali = p.s5AL[(g * 64 + lane) * 2 + 1];
    float xr = 0.f, xi = 0.f;
    float2* st = (float2*)(p.s5st + ((size_t)bg * NCH5 * 64 + lane) * 2);
#pragma unroll 1
    for (int c0 = 0; c0 < NCH5; c0 += 8) {
      float2 e[8];
#pragma unroll
      for (int q = 0; q < 8; q++) e[q] = st[(size_t)(c0 + q) * 64];
#pragma unroll
      for (int q = 0; q < 8; q++) {
        st[(size_t)(c0 + q) * 64] = make_float2(xr, xi);
        float nr = alr * xr - ali * xi + e[q].x, ni = alr * xi + ali * xr + e[q].y;
        xr = nr; xi = ni;
      }
    }
  }
}

template <bool PASS2>
DI void lru_item(const Params& p, int l, int item, int lane, const bf16_t* xl, float* wxs) {
  const int b = item / (8 * NCHL), blk = (item / NCHL) % 8, c = item % NCHL;
  const int ch = blk * 64 + lane;
  unsigned wpa[32], wpx[32];
  {
    const float* pa = p.in[I_LRU_W_A] + ((size_t)l * 8 + blk) * 4096;
    const float* px = p.in[I_LRU_W_X] + ((size_t)l * 8 + blk) * 4096;
    int lo_ = lane; asm volatile("" : "+v"(lo_));
#pragma unroll
    for (int m = 0; m < 32; m++) {
      wpa[m] = (unsigned)f2bf(pa[(2 * m) * 64 + lo_]) | ((unsigned)f2bf(pa[(2 * m + 1) * 64 + lo_]) << 16);
      wpx[m] = (unsigned)f2bf(px[(2 * m) * 64 + lo_]) | ((unsigned)f2bf(px[(2 * m + 1) * 64 + lo_]) << 16);
      if ((m & 7) == 7) asm volatile("" ::: "memory");
    }
  }
  const float* cw = p.in[I_LRU_CONV_W] + (size_t)l * 4 * 512;
  const float cw0 = cw[ch], cw1 = cw[512 + ch], cw2 = cw[1024 + ch], cw3 = cw[1536 + ch];
  const float cb = p.in[I_LRU_CONV_B][l * 512 + ch];
  const float ba = p.in[I_LRU_B_A][l * 512 + ch], bx = p.in[I_LRU_B_X][l * 512 + ch];
  const float sp = softplusf_(-p.in[I_LRU_LAM][l * 512 + ch]);
  const size_t tok0 = (size_t)b * SEQ + (size_t)c * LCL;
  float x1 = 0.f, x2 = 0.f, x3 = 0.f;
  if (c > 0) {
    x1 = bf2f(xl[(tok0 - 1) * 512 + ch]); x2 = bf2f(xl[(tok0 - 2) * 512 + ch]); x3 = bf2f(xl[(tok0 - 3) * 512 + ch]);
  }
  float* st = p.lrust + ((size_t)(b * 512 + ch) * NCHL + c) * 2;
  float hs = PASS2 ? st[1] : 0.f;
  float aprod = 1.f;
  float xn = bf2f(xl[tok0 * 512 + ch]);
#pragma unroll 1
  for (int t = 0; t < LCL; t++) {
    const float x0 = xn;
    if (t + 1 < LCL) xn = bf2f(xl[(tok0 + t + 1) * 512 + ch]);
    const float xc = cw3 * x0 + cw2 * x1 + cw1 * x2 + cw0 * x3 + cb;
    x3 = x2; x2 = x1; x1 = x0;
    float ra0 = ba, ra1 = 0.f, rx0 = bx, rx1 = 0.f;
    const unsigned xb16 = (unsigned)f2bf(xc);
    const unsigned xnb = (unsigned)__shfl_xor((int)xb16, 1);
    const unsigned xpk = xb16 | (xnb << 16);
#pragma unroll
    for (int m = 0; m < 32; m += 2) {
      const bf2_t xa = __builtin_bit_cast(bf2_t, (unsigned)__builtin_amdgcn_readlane((int)xpk, 2 * m));
      const bf2_t xb = __builtin_bit_cast(bf2_t, (unsigned)__builtin_amdgcn_readlane((int)xpk, 2 * m + 2));
      ra0 = __builtin_amdgcn_fdot2_f32_bf16(xa, __builtin_bit_cast(bf2_t, wpa[m]), ra0, false);
      rx0 = __builtin_amdgcn_fdot2_f32_bf16(xa, __builtin_bit_cast(bf2_t, wpx[m]), rx0, false);
      ra1 = __builtin_amdgcn_fdot2_f32_bf16(xb, __builtin_bit_cast(bf2_t, wpa[m + 1]), ra1, false);
      rx1 = __builtin_amdgcn_fdot2_f32_bf16(xb, __builtin_bit_cast(bf2_t, wpx[m + 1]), rx1, false);
    }
    const float rg = sigmoidf_(ra0 + ra1), ig = sigmoidf_(rx0 + rx1);
    const float la = -8.f * rg * sp;
    const float a = __expf(la);
    const float inp = sqrtf(fmaxf(1.f - a * a, 0.f)) * (ig * xc);
    hs = a * hs + inp;
    if (PASS2) p.yd[(tok0 + t) * 512 + ch] = f2bf(hs);
    else aprod *= a;
  }
  if (!PASS2) { st[0] = aprod; st[1] = hs; }
}

DI void lru_carry(const Params& p) {
  const int gt = blockIdx.x * 256 + tidx();
  if (gt >= 4096 && gt < 4096 + 1024) {
    const int bc = gt - 4096;
    float2* st = (float2*)(p.lrust + (size_t)bc * NCHL * 2);
    float hcur = 0.f;
#pragma unroll 1
    for (int c0 = 0; c0 < NCHL; c0 += 8) {
      float2 e[8];
#pragma unroll
      for (int q = 0; q < 8; q++) e[q] = st[c0 + q];
#pragma unroll
      for (int q = 0; q < 8; q++) {
        st[c0 + q] = make_float2(e[q].x, hcur);
        hcur = e[q].x * hcur + e[q].y;
      }
    }
  }
}

template <bool PASS2>
DI void rwkv_item(const Params& p, int l, int item, int lane, const bf16_t* rkv, const bf16_t* lo2, float* rwst) {
  const int b = item / (8 * NCHR), head = (item / NCHR) % 8, c = item % NCHR;
  const int ch = head * 64 + lane;
  const float mu_r = p.in[I_RW_MU_RKV][(size_t)l * 1536 + ch], mu_k = p.in[I_RW_MU_RKV][(size_t)l * 1536 + 512 + ch];
  const float kkw = p.in[I_RW_K_K][l * 512 + ch], kaw = p.in[I_RW_K_A][l * 512 + ch];
  const float rkw = p.in[I_RW_R_K][l * 512 + ch];
  const float gnw = p.in[I_RW_GN_W][l * 512 + ch], gnb = p.in[I_RW_GN_B][l * 512 + ch];
  const size_t tok0 = (size_t)b * SEQ + (size_t)c * LCR;
  float* stS = rwst + ((size_t)((b * 8 + head) * NCHR + c)) * 4096;
  float* stP = (float*)p.yc + ((size_t)((b * 8 + head) * NCHR + c)) * 4096;
  float S[64], P[64];
#pragma unroll
  for (int j = 0; j < 64; j++) { S[j] = 0.f; P[j] = (j == lane) ? 1.f : 0.f; }
  if (PASS2 && c > 0) {
    const float4* sp = (const float4*)(stS - 4096 + lane * 64);
#pragma unroll
    for (int j = 0; j < 16; j++) { float4 v = sp[j]; S[4 * j] = v.x; S[4 * j + 1] = v.y; S[4 * j + 2] = v.z; S[4 * j + 3] = v.w; }
  }
  float rp_prev = 0.f, kp_prev = 0.f;
  if (c > 0) { rp_prev = bf2f(rkv[(tok0 - 1) * 1536 + ch]); kp_prev = bf2f(rkv[(tok0 - 1) * 1536 + 512 + ch]); }
  const bf16_t* ewb = lo2; const bf16_t* ab = lo2 + (size_t)TOK * 512; const bf16_t* gb = lo2 + (size_t)2 * TOK * 512;
  struct Raw { bf16_t rp, kp, v, ew, a, g; };
  struct Der { float rr, wdec, kf, av, bv, v, gg; };
  auto load_raw = [&](size_t tk) __attribute__((always_inline)) {
    Raw x;
    x.rp = rkv[tk * 1536 + ch]; x.kp = rkv[tk * 1536 + 512 + ch]; x.v = p.vbuf[tk * 512 + ch];
    x.ew = ewb[tk * 512 + ch]; x.a = ab[tk * 512 + ch]; x.g = PASS2 ? gb[tk * 512 + ch] : (bf16_t)0;
    return x;
  };
  auto derive = [&](const Raw& x, float rpp, float kpp) __attribute__((always_inline)) {
    Der d;
    const float rp = bf2f(x.rp), kp = bf2f(x.kp), a = bf2f(x.a);
    d.rr = rp + (rpp - rp) * mu_r;
    const float k = kp + (kpp - kp) * mu_k;
    d.wdec = __expf(-bf2f(x.ew));
    float kkv = k * kkw;
    const float nrm = wave_sum(kkv * kkv);
    kkv *= rsqrtf(fmaxf(nrm, 1e-24f));
    d.kf = k * (1.f + (a - 1.f) * kaw);
    d.av = -kkv; d.bv = kkv * a;
    d.v = bf2f(x.v); d.gg = bf2f(x.g);
    return d;
  };
  Raw rawB = load_raw(tok0);
  Der cur = derive(rawB, rp_prev, kp_prev);
  float rpA = bf2f(rawB.rp), kpA = bf2f(rawB.kp);
  rawB = load_raw(tok0 + 1);
#pragma unroll 1
  for (int t = 0; t < LCR; t++) {
    Raw rawC = rawB;
    if (t + 2 < LCR) rawC = load_raw(tok0 + t + 2);
    Der nxt = cur;
    if (t + 1 < LCR) nxt = derive(rawB, rpA, kpA);
    const float rr = cur.rr, wdec = cur.wdec, kf = cur.kf, av = cur.av, bv = cur.bv, v = cur.v, gg = cur.gg;
    float sa0 = 0.f, sa1 = 0.f, pa0 = 0.f, pa1 = 0.f;
#pragma unroll
    for (int j = 0; j < 64; j += 2) {
      const float a0 = rl(av, j), a1 = rl(av, j + 1);
      sa0 += S[j] * a0; sa1 += S[j + 1] * a1;
      if (!PASS2) { pa0 += P[j] * a0; pa1 += P[j + 1] * a1; }
    }
    const float sa = sa0 + sa1, pa = pa0 + pa1;
    float y0 = 0.f, y1 = 0.f;
#pragma unroll
    for (int j = 0; j < 64; j += 2) {
      const float w0 = rl(wdec, j), b0 = rl(bv, j), k0 = rl(kf, j);
      const float w1 = rl(wdec, j + 1), b1 = rl(bv, j + 1), k1 = rl(kf, j + 1);
      S[j] = S[j] * w0 + sa * b0 + v * k0;
      S[j + 1] = S[j + 1] * w1 + sa * b1 + v * k1;
      if (!PASS2) {
        P[j] = P[j] * w0 + pa * b0;
        P[j + 1] = P[j + 1] * w1 + pa * b1;
      } else {
        y0 += S[j] * rl(rr, j); y1 += S[j + 1] * rl(rr, j + 1);
      }
    }
    if (PASS2) {
      const float y = y0 + y1;
      float s1 = y, s2 = y * y, s3 = rr * kf * rkw;
#pragma unroll
      for (int off = 32; off >= 1; off >>= 1) {
        const float t1 = __shfl_xor(s1, off), t2 = __shfl_xor(s2, off), t3 = __shfl_xor(s3, off);
        s1 += t1; s2 += t2; s3 += t3;
      }
      const float mean = s1 * (1.f / 64.f);
      const float var = fmaxf(s2 * (1.f / 64.f) - mean * mean, 0.f);
      const float yn = (y - mean) * rsqrtf(var + 64e-5f) * gnw + gnb;
      const float bs = s3;
      p.yc[(tok0 + t) * 512 + ch] = f2bf((yn + bs * v) * gg);
    }
    rpA = bf2f(rawB.rp); kpA = bf2f(rawB.kp); rawB = rawC; cur = nxt;
  }
  if (!PASS2) {
    float4* sp = (float4*)(stS + lane * 64);
    float4* pp = (float4*)(stP + lane * 64);
#pragma unroll
    for (int j = 0; j < 16; j++) {
      sp[j] = make_float4(S[4 * j], S[4 * j + 1], S[4 * j + 2], S[4 * j + 3]);
      pp[j] = make_float4(P[4 * j], P[4 * j + 1], P[4 * j + 2], P[4 * j + 3]);
    }
  }
}

DI void rwkv_carry(const Params& p, float* rwst) {
  const int lane = tidx() & 63, wave = tidx() >> 6;
  const int wsel = ((int)blockIdx.x < (int)(gridDim.x >> 1)) ? wave : wave - 2;
  if (wsel >= 0 && wsel < 2)
  for (int item = wsel * gridDim.x + blockIdx.x; item < 1024; item += gridDim.x * 2) {
    const int itu = __builtin_amdgcn_readfirstlane(item);
    const int bh = itu >> 6, i = itu & 63;
    float* stS = rwst + (size_t)bh * NCHR * 4096 + i * 64 + lane;
    const float* stP = (const float*)p.yc + (size_t)bh * NCHR * 4096 + lane;
    float v = 0.f;
    float pc[64], sc;
#pragma unroll
    for (int mm = 0; mm < 64; mm++) pc[mm] = stP[mm * 64];
    sc = stS[0];
#pragma unroll 1
    for (int c = 0; c < NCHR - 1; c++) {
      float pn[64], sn = 0.f;
      const bool more = (c + 2 < NCHR);
#pragma unroll
      for (int mm = 0; mm < 64; mm++) pn[mm] = more ? stP[(size_t)(c + 1) * 4096 + mm * 64] : 0.f;
      if (more) sn = stS[(size_t)(c + 1) * 4096];
      float acc0 = sc, acc1 = 0.f;
#pragma unroll
      for (int mm = 0; mm < 64; mm += 2) {
        acc0 += rl(v, mm) * pc[mm];
        acc1 += rl(v, mm + 1) * pc[mm + 1];
      }
      v = acc0 + acc1;
      stS[(size_t)c * 4096] = v;
#pragma unroll
      for (int mm = 0; mm < 64; mm++) pc[mm] = pn[mm];
      sc = sn;
    }
  }
}


#define XB_TMO      128
#define XB_XCNT(j)  (256  + 64 * (j))
#define XB_XSUB(j)  (1280 + 64 * (j))
#define XB_XGEN(j)  (2304 + 64 * (j))
#define XB_TOP      3328
#define XB_TOPGEN   3392
#define XCD_BAR_WORDS 3456
#define XB_SPIN_CAP (1u << 22)
#define LAS __attribute__((address_space(3)))
DI unsigned xb_ld(unsigned* p)              { return __hip_atomic_load(p, __ATOMIC_RELAXED, __HIP_MEMORY_SCOPE_AGENT); }
DI unsigned xb_add(unsigned* p, unsigned v) { return __hip_atomic_fetch_add(p, v, __ATOMIC_RELAXED, __HIP_MEMORY_SCOPE_AGENT); }
DI unsigned xb_xcc_id() { return (unsigned)__builtin_amdgcn_s_getreg((3 << 11) | 20) & 0xFu; }
#define XB_SPIN(cond, bar) do { unsigned _sp = 0; while (cond) { __builtin_amdgcn_s_sleep(1); \
    if ((++_sp & 255u) == 0u) { if (xb_ld(&(bar)[XB_TMO])) break; if (_sp > XB_SPIN_CAP) { atomicAdd(&(bar)[XB_TMO], 1u); break; } } } } while (0)
struct XcdBarrier { unsigned* bar; unsigned x; volatile LAS unsigned* st; };
DI XcdBarrier xcd_barrier_post(unsigned* bar, volatile LAS unsigned* st) {
  XcdBarrier b; b.bar = bar; b.x = xb_xcc_id(); b.st = st;
  if (__builtin_amdgcn_workitem_id_x() == 0) (void)xb_add(&bar[XB_XCNT(b.x)], 1u);
  return b;
}
DI void xcd_barrier_complete(unsigned* bar, unsigned x, unsigned& nloc, unsigned& nx) {
  const unsigned G = gridDim.x * gridDim.y * gridDim.z;
  unsigned sum, cnt, mine, sp = 0u;
  for (;;) {
    sum = 0u; cnt = 0u; mine = 0u;
#pragma unroll
    for (unsigned j = 0; j < 16; ++j) { const unsigned c = xb_ld(&bar[XB_XCNT(j)]); sum += c; cnt += (c > 0u) ? 1u : 0u; mine = (j == x) ? c : mine; }
    if (sum == G) break;
    __builtin_amdgcn_s_sleep(1);
    if ((++sp & 255u) == 0u) { if (xb_ld(&bar[XB_TMO])) break; if (sp > XB_SPIN_CAP) { atomicAdd(&bar[XB_TMO], 1u); break; } }
  }
  nloc = mine > 0u ? mine : 1u; nx = cnt > 0u ? cnt : 1u;
}
DI void xcd_barrier(const XcdBarrier& b) {
  asm volatile("s_waitcnt vmcnt(0)" ::: "memory");
  __syncthreads();
  if (__builtin_amdgcn_workitem_id_x() == 0) {
    unsigned* bar = b.bar;
    __builtin_amdgcn_s_waitcnt(0);
    unsigned nloc = b.st[0], nx = b.st[1];
    if (nloc == 0u) { xcd_barrier_complete(bar, b.x, nloc, nx); b.st[0] = nloc; b.st[1] = nx; }
    const unsigned old = xb_add(&bar[XB_XSUB(b.x)], 1u);
    const unsigned gen = old / nloc;
    if (old + 1u == (gen + 1u) * nloc) {
      __builtin_amdgcn_fence(__ATOMIC_RELEASE, "agent");
      asm volatile("s_waitcnt vmcnt(0)" ::: "memory");
      const unsigned og = xb_add(&bar[XB_TOP], 1u);
      const unsigned tg = og / nx;
      if (og + 1u == (tg + 1u) * nx) xb_add(&bar[XB_TOPGEN], 1u);
      else XB_SPIN(xb_ld(&bar[XB_TOPGEN]) == tg, bar);
      __builtin_amdgcn_fence(__ATOMIC_ACQUIRE, "agent");
      xb_add(&bar[XB_XGEN(b.x)], 1u);
      asm volatile("s_waitcnt vmcnt(0)" ::: "memory");
    } else {
      XB_SPIN(xb_ld(&bar[XB_XGEN(b.x)]) == gen, bar);
      __builtin_amdgcn_fence(__ATOMIC_ACQUIRE, "agent");
      asm volatile("s_waitcnt vmcnt(0)" ::: "memory");
    }
  }
  __syncthreads();
}

template <int Q>
DI void run_phase(const Params& p, int l, bf16_t* sm) {
  const int lane = tidx() & 63, wave = tidx() >> 6;
  char* TR = p.TR;
  const size_t MB = 1048576;
  bf16_t* ubuf = (bf16_t*)TR;
  bf16_t* xlbuf = (bf16_t*)(TR + 32 * MB);
  bf16_t* ybpre = (bf16_t*)(TR + 64 * MB);
  bf16_t* rkv = (bf16_t*)(TR + 96 * MB);
  bf16_t* lo1 = (bf16_t*)(TR + 192 * MB);
  float* rwst = (float*)(TR + 192 * MB);
  bf16_t* lo2 = (bf16_t*)TR;
  bf16_t* merged = (bf16_t*)TR;
  bf16_t* ffh = (bf16_t*)TR;
  const float* Xin = (l == 0) ? p.in[I_X] : p.X;
  if (Q == 0) { rmsnorm_rows(Xin, p.in[I_NORM_MIX] + l * DM, p.h, nullptr); if (l == 0) phase_prep(p, 0, (float*)sm, 1); }
  if (Q == 2) phase_gemm_qkv(p, sm);
  if (Q == 3) phase_attention(p, sm);
  if (Q == 5) { phase_attn_combine(p); int base = 0; phase_gemm_plain(p.h, 1024, p.Wux, 8, ubuf, xlbuf, 512, 512, sm, base); }
  if (Q == 6) {
    for (int it = wave * gridDim.x + blockIdx.x; it < 16 * NCHL; it += gridDim.x * 4) lru_item<false>(p, l, __builtin_amdgcn_readfirstlane(it), lane, xlbuf, (float*)sm + wave * 4096);
    for (int it = first_item(16 * NCHL, wave * gridDim.x + blockIdx.x, gridDim.x * 4); it < 64 * NCH5; it += gridDim.x * 4)
      s5_item<false>(p, l, __builtin_amdgcn_readfirstlane(it), lane, ubuf, ybpre, sm + wave * (32 * XSP), (float*)((char*)sm + 34816) + wave * 2176);
  }
  if (Q == 7) { s5_carry(p); lru_carry(p); }
  if (Q == 8) {
    for (int it = wave * gridDim.x + blockIdx.x; it < 16 * NCHL; it += gridDim.x * 4) lru_item<true>(p, l, __builtin_amdgcn_readfirstlane(it), lane, xlbuf, (float*)sm + wave * 4096);
    for (int it = first_item(16 * NCHL, wave * gridDim.x + blockIdx.x, gridDim.x * 4); it < 64 * NCH5; it += gridDim.x * 4)
      s5_item<true>(p, l, __builtin_amdgcn_readfirstlane(it), lane, ubuf, ybpre, sm + wave * (32 * XSP), (float*)((char*)sm + 34816) + wave * 2176);
  }
  if (Q == 9) {
    int base = 0;
    phase_gemm_plain(p.h, 1024, p.Wrkv, 12, rkv, rkv, 1 << 30, 1536, sm, base);
    phase_lora1(p, lo1, sm, base);
    phase_glu(p, l, ybpre, sm, base);
  }
  if (Q == 10) {
    int base = 0;
    phase_lora2(p, l, lo1, lo2, rkv, sm, base);
    if (l == 0) phase_vlerp(p, l, rkv);
  }
  const int wsel = ((int)blockIdx.x < (int)(gridDim.x >> 1)) ? wave : wave - 2;
  if (Q == 11) {
    for (int it = wave * gridDim.x + blockIdx.x; it < 16 * NCHR; it += gridDim.x * 4) rwkv_item<false>(p, l, __builtin_amdgcn_readfirstlane(it), lane, rkv, lo2, rwst);
  }
  if (Q == 12) { rwkv_carry(p, rwst); phase_prep(p, l, (float*)sm, 2); }
  if (Q == 13) {
    for (int it = wave * gridDim.x + blockIdx.x; it < 16 * NCHR; it += gridDim.x * 4) rwkv_item<true>(p, l, __builtin_amdgcn_readfirstlane(it), lane, rkv, lo2, rwst);
  }
  if (Q == 14) phase_merge(p, merged, sm);
  if (Q == 15) phase_gemm_resid(merged, 1024, p.WoutT, Xin, p.X, sm);
  if (Q == 16) { rmsnorm_rows(p.X, p.in[I_NORM_FFN] + l * DM, p.h, nullptr); if (l == 0) phase_prep(p, 1, (float*)sm, 1); }
  if (Q == 17) phase_ffn_up(p, ffh, sm);
  if (Q == 18) phase_gemm_resid(ffh, DFF, p.FfnDown, p.X, p.X, sm);
  if (Q == 19) rmsnorm_rows(p.X, p.in[I_NORM_FINAL], nullptr, p.X);
}

#if MEGA
#define PH(Q) run_phase<Q>(p, l, (bf16_t*)smem_raw); xcd_barrier(xb);
__global__ void __launch_bounds__(256, 2) fwd_megakernel(KArgs k) {
  __shared__ __attribute__((aligned(16))) char smem_raw[SMEM_BYTES];
  __shared__ uint4 xb_words;
  cg::grid_group grid = cg::this_grid();
  const Params p = make_params(k);
  if (__builtin_amdgcn_workitem_id_x() == 0) xb_words = make_uint4(0u, 0u, 0u, 0u);
  __syncthreads();
  const XcdBarrier xb = xcd_barrier_post((unsigned*)(k.ws + O_bar), (volatile LAS unsigned*)&xb_words);
  {
    const int l = 0;
    run_phase<0>(p, l, (bf16_t*)smem_raw); grid.sync();
    PH(2) PH(3) PH(5) PH(6) PH(7) PH(8) PH(9) PH(10) PH(11) PH(12) PH(13) PH(14) PH(15) PH(16) PH(17) PH(18)
  }
  {
    const int l = 1;
    PH(0) PH(2) PH(3) PH(5) PH(6) PH(7) PH(8) PH(9) PH(10) PH(11) PH(12) PH(13) PH(14) PH(15) PH(16) PH(17) PH(18)
  }
  run_phase<19>(p, 1, (bf16_t*)smem_raw);
}
#else
template <int Q>
__global__ void __launch_bounds__(256, 2) fwd_phase_kernel(KArgs k, int l) {
  __shared__ __attribute__((aligned(16))) char smem_raw[SMEM_BYTES];
  const Params p = make_params(k);
  run_phase<Q>(p, l, (bf16_t*)smem_raw);
}
#endif

extern "C" void kernel_launch(void* const* d_in, const int* in_sizes, int n_in, void* d_out, int out_size,
                              void* d_ws, size_t ws_size, hipStream_t stream) {
  KArgs p;
  memset(&p, 0, sizeof(p));
  for (int i = 0; i < I_COUNT && i < n_in; i++) p.in[i] = (const float*)d_in[i];
  p.ws = (char*)d_ws;
  p.X = (float*)d_out;
  if (WS_NEED > ws_size) { fprintf(stderr, "workspace too small: need %zu have %zu\n", (size_t)WS_NEED, ws_size); return; }
#if MEGA
  static int grid_blocks = 0;
  if (!grid_blocks) {
    int dev = 0, cus = 0, per_cu = 0;
    hipGetDevice(&dev);
    hipDeviceGetAttribute(&cus, hipDeviceAttributeMultiprocessorCount, dev);
    hipOccupancyMaxActiveBlocksPerMultiprocessor(&per_cu, fwd_megakernel, 256, 0);
    if (per_cu > 2) per_cu = 2;
    grid_blocks = (cus * per_cu) & ~7;
  }
  hipMemsetAsync((char*)d_ws + O_bar, 0, 16384, stream);
  void* args[] = {&p};
  hipError_t e = hipLaunchCooperativeKernel((void*)fwd_megakernel, dim3(grid_blocks), dim3(256), args, 0, stream);
  if (e != hipSuccess) fprintf(stderr, "cooperative launch failed: %s (grid %d)\n", hipGetErrorString(e), grid_blocks);
#else
#define LP_(Q) fwd_phase_kernel<Q><<<512, 256, 0, stream>>>(p, l);
  for (int l = 0; l < 2; l++) {
    LP_(0) LP_(2) LP_(3) LP_(5) LP_(6) LP_(7) LP_(8) LP_(9) LP_(10) LP_(11) LP_(12) LP_(13) LP_(14) LP_(15) LP_(16) LP_(17) LP_(18)
  }
  fwd_phase_kernel<19><<<512, 256, 0, stream>>>(p, 1);
#endif
}
```
